# Optimizing an MI355X kernel written in HIP

```python
import jax, jax.numpy as jnp
from jax import lax
import numpy as np

D_MODEL = 1024
BATCH = 4
SEQ = 4096
DEPTH = 1

MLSTM_HEADS = 4
MLSTM_QK_DIM = 128
MLSTM_V_DIM = D_MODEL // MLSTM_HEADS
MLSTM_CHUNK = 64
CONV_WIDTH = 4
MLA_HEADS = 8
MLA_NOPE_DIM = 128
MLA_ROPE_DIM = 64
MLA_V_DIM = D_MODEL // MLA_HEADS
MLA_Q_RANK = 384
MLA_KV_RANK = 256
ROPE_THETA = 10000.0
ATTN_BLOCK = 128
D_FF = 4 * D_MODEL
EPS = 1e-6
N_MOD = 6

MA_QK = MLSTM_HEADS * MLSTM_QK_DIM
MA_V = MLSTM_HEADS * MLSTM_V_DIM
SPLIT_SIZES = (MA_QK, MA_QK, MA_V, MA_V, MLSTM_HEADS, MLSTM_HEADS,
               MLA_Q_RANK, MLA_KV_RANK, MLA_ROPE_DIM, D_MODEL, D_MODEL)
D_IN = sum(SPLIT_SIZES)
SPLIT_IDX = tuple(int(v) for v in np.cumsum(SPLIT_SIZES)[:-1])

kernel_name = 'hybrid_mlstm_mla_block'


def rmsnorm(x, w):
    xf = x.astype(jnp.float32)
    y = xf * lax.rsqrt(jnp.mean(xf * xf, axis=-1, keepdims=True) + EPS)
    return (y * w.astype(jnp.float32)).astype(x.dtype)


def causal_dwconv(x, w, b):
    ch = x.shape[-1]
    y = lax.conv_general_dilated(x, w[:, None, :].astype(x.dtype), window_strides=(1,),
                                 padding=[(CONV_WIDTH - 1, 0)],
                                 dimension_numbers=('NWC', 'WIO', 'NWC'),
                                 feature_group_count=ch)
    return y + b.astype(x.dtype)


def rope(x, positions):
    half = x.shape[-1] // 2
    inv_freq = ROPE_THETA ** (-jnp.arange(half, dtype=jnp.float32) / half)
    ang = positions.astype(jnp.float32)[:, None] * inv_freq[None, :]
    cos, sin = jnp.cos(ang), jnp.sin(ang)
    x1, x2 = x[..., :half], x[..., half:]
    return jnp.concatenate([x1 * cos - x2 * sin, x2 * cos + x1 * sin], axis=-1)


def mlstm_branch(q, k, v, o_pre, i_pre, f_pre, head_norm_w):
    bsz, seq, _ = q.shape
    H, L = MLSTM_HEADS, MLSTM_CHUNK
    nc = seq // L
    f32 = jnp.float32

    def chunks(t, d):
        return t.astype(f32).reshape(bsz, nc, L, H, d).transpose(1, 0, 3, 2, 4)

    def gchunks(t):
        return t.astype(f32).reshape(bsz, nc, L, H).transpose(1, 0, 3, 2)

    qc = chunks(q, MLSTM_QK_DIM)
    kc = chunks(k, MLSTM_QK_DIM) * (MLSTM_QK_DIM ** -0.5)
    vc = chunks(v, MLSTM_V_DIM)
    igc = gchunks(i_pre)
    lfc = jax.nn.log_sigmoid(gchunks(f_pre))
    causal = jnp.tril(jnp.ones((L, L), dtype=bool))

    def step(carry, xs):
        C, n, m = carry
        qb, kb, vb, ib, lb = xs
        b = jnp.cumsum(lb, axis=-1)
        a = b + m[..., None]
        D = jnp.where(causal, b[..., :, None] - b[..., None, :] + ib[..., None, :], -jnp.inf)
        m_out = jnp.maximum(a, jnp.max(D, axis=-1))
        s = jnp.einsum('bhtd,bhsd->bhts', qb, kb) * jnp.exp(D - m_out[..., None])
        w_inter = jnp.exp(a - m_out)
        num = (jnp.einsum('bhts,bhsv->bhtv', s, vb)
               + w_inter[..., None] * jnp.einsum('bhvd,bhtd->bhtv', C, qb))
        den = jnp.sum(s, axis=-1) + w_inter * jnp.einsum('bhd,bhtd->bht', n, qb)
        h = num / jnp.maximum(jnp.abs(den), jnp.exp(-m_out))[..., None]
        g_prev = b[..., -1] + m
        g = b[..., -1:] - b + ib
        m_new = jnp.maximum(g_prev, jnp.max(g, axis=-1))
        wk = jnp.exp(g - m_new[..., None])
        decay = jnp.exp(g_prev - m_new)
        C_new = decay[..., None, None] * C + jnp.einsum('bhs,bhsv,bhsd->bhvd', wk, vb, kb)
        n_new = decay[..., None] * n + jnp.einsum('bhs,bhsd->bhd', wk, kb)
        return (C_new, n_new, m_new), h

    init = (jnp.zeros((bsz, H, MLSTM_V_DIM, MLSTM_QK_DIM), f32),
            jnp.zeros((bsz, H, MLSTM_QK_DIM), f32),
            jnp.zeros((bsz, H), f32))
    _, h = lax.scan(step, init, (qc, kc, vc, igc, lfc))
    h = h.transpose(1, 0, 3, 2, 4).reshape(bsz, seq, H, MLSTM_V_DIM)
    h = h * lax.rsqrt(jnp.mean(h * h, axis=-1, keepdims=True) + EPS)
    h = h.reshape(bsz, seq, MA_V) * head_norm_w.astype(f32)
    y = jax.nn.sigmoid(o_pre.astype(f32)) * h
    return y.astype(q.dtype)


def mla_branch(c_q, c_kv, k_rope, q_norm_w, kv_norm_w, w_uq, w_ukv):
    bsz, seq, _ = c_q.shape
    H = MLA_HEADS
    f32 = jnp.float32
    positions = jnp.arange(seq, dtype=jnp.int32)
    q = (rmsnorm(c_q, q_norm_w) @ w_uq).reshape(bsz, seq, H, MLA_NOPE_DIM + MLA_ROPE_DIM)
    kv = (rmsnorm(c_kv, kv_norm_w) @ w_ukv).reshape(bsz, seq, H, MLA_NOPE_DIM + MLA_V_DIM)
    q = q.astype(f32).transpose(0, 2, 1, 3)
    kv = kv.astype(f32).transpose(0, 2, 1, 3)
    q_nope, q_pe = q[..., :MLA_NOPE_DIM], rope(q[..., MLA_NOPE_DIM:], positions)
    k_nope, v = kv[..., :MLA_NOPE_DIM], kv[..., MLA_NOPE_DIM:]
    k_pe = rope(k_rope.astype(f32), positions)
    scale = (MLA_NOPE_DIM + MLA_ROPE_DIM) ** -0.5
    outs = []
    for i in range(seq // ATTN_BLOCK):
        start, end = i * ATTN_BLOCK, (i + 1) * ATTN_BLOCK
        sc = (jnp.einsum('bhqd,bhkd->bhqk', q_nope[:, :, start:end], k_nope[:, :, :end])
              + jnp.einsum('bhqr,bkr->bhqk', q_pe[:, :, start:end], k_pe[:, :end])) * scale
        mask = (start + jnp.arange(ATTN_BLOCK))[:, None] >= jnp.arange(end)[None, :]
        p = jax.nn.softmax(jnp.where(mask, sc, -jnp.inf), axis=-1)
        outs.append(jnp.einsum('bhqk,bhkv->bhqv', p, v[:, :, :end]))
    o = jnp.concatenate(outs, axis=2)
    return o.transpose(0, 2, 1, 3).reshape(bsz, seq, H * MLA_V_DIM).astype(c_q.dtype)


def token_mixer(h, w_in, conv_w, conv_b, gate_b, head_norm_w, q_norm_w, kv_norm_w,
                w_uq, w_ukv, w_out):
    (q_a, k_a, v_a, o_a, i_a, f_a, c_q, c_kv, k_pe, g_a, g_b) = jnp.split(h @ w_in, SPLIT_IDX, axis=-1)
    qk = jax.nn.silu(causal_dwconv(jnp.concatenate([q_a, k_a], axis=-1), conv_w, conv_b))
    q_a, k_a = qk[..., :MA_QK], qk[..., MA_QK:]
    i_a = i_a + gate_b[:MLSTM_HEADS].astype(h.dtype)
    f_a = f_a + gate_b[MLSTM_HEADS:].astype(h.dtype)
    y_a = mlstm_branch(q_a, k_a, v_a, o_a, i_a, f_a, head_norm_w)
    y_b = mla_branch(c_q, c_kv, k_pe, q_norm_w, kv_norm_w, w_uq, w_ukv)
    y = jax.nn.sigmoid(g_a) * y_a + jax.nn.sigmoid(g_b) * y_b
    return y @ w_out


def setup_inputs(seed: int = 0) -> dict:
    key = jax.random.key(seed)
    ks = jax.random.split(key, 24)
    nrm = lambda k, shape, s: jax.random.normal(k, shape, jnp.float32) * s
    gain = lambda k, n: 1.0 + nrm(k, (DEPTH, n), 0.05)
    gate_b = jnp.concatenate([nrm(ks[10], (DEPTH, MLSTM_HEADS), 0.1),
                              3.0 + nrm(ks[11], (DEPTH, MLSTM_HEADS), 0.5)], axis=-1)
    return {
        'x': nrm(ks[0], (BATCH, SEQ, D_MODEL), 1.0),
        'c': nrm(ks[1], (BATCH, D_MODEL), 1.0),
        'w_ada': nrm(ks[2], (DEPTH, D_MODEL, N_MOD * D_MODEL), 0.3 * D_MODEL ** -0.5),
        'b_ada': nrm(ks[3], (DEPTH, N_MOD * D_MODEL), 0.02),
        'norm_pre_mix': gain(ks[4], D_MODEL),
        'norm_post_mix': gain(ks[5], D_MODEL),
        'norm_pre_mlp': gain(ks[6], D_MODEL),
        'norm_post_mlp': gain(ks[7], D_MODEL),
        'w_in': nrm(ks[8], (DEPTH, D_MODEL, D_IN), D_MODEL ** -0.5),
        'mlstm_conv_w': nrm(ks[9], (DEPTH, CONV_WIDTH, 2 * MA_QK), CONV_WIDTH ** -0.5),
        'mlstm_conv_b': nrm(ks[12], (DEPTH, 2 * MA_QK), 0.02),
        'mlstm_gate_b': gate_b,
        'mlstm_head_norm': gain(ks[13], MA_V),
        'mla_q_norm': gain(ks[14], MLA_Q_RANK),
        'mla_kv_norm': gain(ks[15], MLA_KV_RANK),
        'w_uq': nrm(ks[16], (DEPTH, MLA_Q_RANK, MLA_HEADS * (MLA_NOPE_DIM + MLA_ROPE_DIM)), MLA_Q_RANK ** -0.5),
        'w_ukv': nrm(ks[17], (DEPTH, MLA_KV_RANK, MLA_HEADS * (MLA_NOPE_DIM + MLA_V_DIM)), MLA_KV_RANK ** -0.5),
        'w_out': nrm(ks[18], (DEPTH, D_MODEL, D_MODEL), D_MODEL ** -0.5),
        'w_ff1': nrm(ks[19], (DEPTH, D_MODEL, D_FF), D_MODEL ** -0.5),
        'w_ff2': nrm(ks[20], (DEPTH, D_FF, D_MODEL), D_FF ** -0.5),
    }


def reference(x, c, w_ada, b_ada, norm_pre_mix, norm_post_mix, norm_pre_mlp, norm_post_mlp,
              w_in, mlstm_conv_w, mlstm_conv_b, mlstm_gate_b, mlstm_head_norm,
              mla_q_norm, mla_kv_norm, w_uq, w_ukv, w_out, w_ff1, w_ff2):
    for l in range(DEPTH):
        mod = jax.nn.silu(c) @ w_ada[l] + b_ada[l]
        sh_m, sc_m, gt_m, sh_f, sc_f, gt_f = [t[:, None, :] for t in jnp.split(mod, N_MOD, axis=-1)]
        h = rmsnorm(x, norm_pre_mix[l]) * (1.0 + sc_m) + sh_m
        y = token_mixer(h, w_in[l], mlstm_conv_w[l], mlstm_conv_b[l], mlstm_gate_b[l],
                        mlstm_head_norm[l], mla_q_norm[l], mla_kv_norm[l],
                        w_uq[l], w_ukv[l], w_out[l])
        x = x + gt_m * rmsnorm(y, norm_post_mix[l])
        h = rmsnorm(x, norm_pre_mlp[l]) * (1.0 + sc_f) + sh_f
        y = jnp.square(jax.nn.relu(h @ w_ff1[l])) @ w_ff2[l]
        x = x + gt_f * rmsnorm(y, norm_post_mlp[l])
    return x
```

```cpp
#include <hip/hip_runtime.h>
#include <cstdio>
#include <cstdint>

constexpr int NWAVES = 8, NTHREADS = 512;
constexpr int BATCH = 4, SEQ = 4096, DM = 1024, M = BATCH * SEQ;
constexpr int DIN = 5832, NIN = 6144;
constexpr int DFF = 4096, NMODC = 6 * DM;
constexpr int QRANK = 384, KVRANK = 256, NQ = 1536, NKV = 2048;
constexpr float EPS = 1e-6f;
constexpr float QSCALE = 0.07216878364870322f * 1.4426950408889634f;
constexpr int NPHASE = 14;

constexpr size_t MiB = 1u << 20, KiB = 1u << 10;
constexpr size_t WS_CTL = 0, CTL_ZERO_BYTES = 1 * MiB;
constexpr size_t WS_MOD = 1 * MiB;
constexpr size_t WS_RSTDQ = 1 * MiB + 128 * KiB, WS_RSTDKV = 1 * MiB + 192 * KiB;
constexpr size_t WS_SCAL = 1 * MiB + 256 * KiB, WS_MST = 1 * MiB + 264 * KiB;
constexpr size_t WS_ROPE = 2 * MiB;
constexpr size_t WS_IF = 3 * MiB, WS_NST = 3 * MiB + 512 * KiB;
constexpr size_t WS_WFF1 = 4 * MiB, WS_WFF2 = 12 * MiB, WS_WOUT = 20 * MiB, WS_WIN = 22 * MiB, WS_WUQ = 34 * MiB, WS_WUKV = 36 * MiB;
constexpr size_t WS_KPE = 38 * MiB, WS_CQ = 40 * MiB, WS_CKV = 52 * MiB;
constexpr size_t WS_H = 60 * MiB;
constexpr size_t WS_QC = 60 * MiB, WS_KC = 76 * MiB;
constexpr size_t WS_QKPRE = 92 * MiB;
constexpr size_t WS_Y = 92 * MiB;
constexpr size_t WS_V = 124 * MiB, WS_OGA = 156 * MiB, WS_GB = 188 * MiB;
constexpr size_t WS_QB = 124 * MiB;
constexpr size_t WS_Y1 = 124 * MiB;
constexpr size_t WS_A2 = 92 * MiB;
constexpr size_t WS_Y2 = 24 * MiB;
constexpr size_t WS_END = 220 * MiB;
constexpr int CW_BAR = 4096;

constexpr int LDS_BYTES = 160 * 1024;
constexpr int MISC_OFF = LDS_BYTES - 256;

#define GAS __attribute__((address_space(1)))
#define LAS __attribute__((address_space(3)))
typedef unsigned short bf16;
typedef unsigned v4u __attribute__((ext_vector_type(4)));
typedef unsigned v2u __attribute__((ext_vector_type(2)));
typedef float f32x4 __attribute__((ext_vector_type(4)));
typedef float f32x16 __attribute__((ext_vector_type(16)));
typedef short bf16x8 __attribute__((ext_vector_type(8)));
typedef short s16x4 __attribute__((ext_vector_type(4)));
typedef GAS unsigned gu32;
#define RLX_AGENT __ATOMIC_RELAXED, __HIP_MEMORY_SCOPE_AGENT
#define LDS_WAIT() asm volatile("s_waitcnt lgkmcnt(0)" ::: "memory")
__device__ __forceinline__ unsigned f2bf(float f) { unsigned u = __builtin_bit_cast(unsigned, f); return (u + 0x7fffu + ((u >> 16) & 1u)) >> 16; }
__device__ __forceinline__ unsigned pk2(float lo, float hi) { return f2bf(lo) | (f2bf(hi) << 16); }
__device__ __forceinline__ float bflo(unsigned w) { return __builtin_bit_cast(float, w << 16); }
__device__ __forceinline__ float bfhi(unsigned w) { return __builtin_bit_cast(float, w & 0xffff0000u); }
__device__ __forceinline__ float bf2f(bf16 v) { return __builtin_bit_cast(float, (unsigned)v << 16); }
__device__ __forceinline__ float wave_sum(float v) {
#pragma unroll
    for (int o = 1; o < 64; o <<= 1) v += __shfl_xor(v, o);
    return v;
}
__device__ __forceinline__ float wave_max(float v) {
#pragma unroll
    for (int o = 1; o < 64; o <<= 1) v = fmaxf(v, __shfl_xor(v, o));
    return v;
}

namespace pg8 {
#define PG8_LAS __attribute__((address_space(3)))
typedef unsigned short bf16_t;
typedef short bf16x8 __attribute__((ext_vector_type(8)));
typedef float f32x4 __attribute__((ext_vector_type(4)));
typedef unsigned u32x4 __attribute__((ext_vector_type(4)));
constexpr int BM = 256, BK = 64, HALF = 128, HTB = HALF * BK * 2  , STAGE_BYTES = 8 * HTB, NXCD = 8, WGM = 8;

__host__ __device__ __forceinline__ int lds_byte(int r, int c) { const int st = (r >> 4) * 2 + (c >> 5), rr = r & 15, cc = c & 31, ob = rr * 64 + cc * 2; return st * 1024 + (ob ^ (((ob >> 9) & 1) << 5)); }
__host__ __device__ __forceinline__ void stage_rc(int b, int& R, int& C) { const int st = b / 1024, sb = b % 1024, swz = sb ^ (((sb >> 9) & 1) << 5); R = (st >> 1) * 16 + swz / 64; C = (st & 1) * 32 + (swz % 64) / 2; }
__host__ __device__ __forceinline__ int perm32(int rho) { const int n = rho >> 4, i = rho & 15; return 8 * (i >> 2) + 4 * n + (i & 3); }

struct Unit { int pm, pn; };
struct Gemm { const bf16_t* A; const bf16_t* Bt; int M, N, K; };

struct StaticOrder {
    int nM, nN, nwg, G, c;
    __host__ __device__ void init(int M, int N, int G_, int c_) { nM = M / BM; nN = N / BM; nwg = nM * nN; G = G_; c = c_; }
    __host__ __device__ bool next(int i, Unit& u) const {
        const long L = (long)i * G + c; if (L >= nwg) return false;
        int wgid = (int)L; { const int q = nwg / NXCD, r = nwg % NXCD, xcd = wgid % NXCD, off = wgid / NXCD; wgid = (xcd < r ? xcd * (q + 1) : r * (q + 1) + (xcd - r) * q) + off; }
        const int nig = WGM * nN, gid = wgid / nig, fm = gid * WGM, gsz = (nM - fm) < WGM ? (nM - fm) : WGM;
        u.pm = fm + ((wgid % nig) % gsz); u.pn = (wgid % nig) / gsz; return true;
    }
    __device__ __forceinline__ void a_ready(const Unit&) const {}
    __device__ __forceinline__ void done(const Unit&) const {}
};

typedef float f32x2_t __attribute__((ext_vector_type(2))); typedef __bf16 bf16x2_t __attribute__((ext_vector_type(2)));
__device__ __forceinline__ unsigned cvt_pk_bf16(float lo, float hi) { f32x2_t v = {lo, hi}; bf16x2_t b = __builtin_convertvector(v, bf16x2_t); return __builtin_bit_cast(unsigned, b); }
__device__ __forceinline__ void store8(bf16_t* p, f32x4 v0, f32x4 v1) {
    u32x4 w; w.x = cvt_pk_bf16(v0[0], v0[1]); w.y = cvt_pk_bf16(v0[2], v0[3]); w.z = cvt_pk_bf16(v1[0], v1[1]); w.w = cvt_pk_bf16(v1[2], v1[3]);
    *(u32x4*)p = w;
}
__device__ __forceinline__ float sigm(float x) { return __builtin_amdgcn_rcpf(1.0f + __expf(-x)); }
__device__ __forceinline__ f32x4 sigm4(f32x4 v) { return (f32x4){sigm(v[0]), sigm(v[1]), sigm(v[2]), sigm(v[3])}; }
__device__ __forceinline__ float logsigm(float x) { return fminf(x, 0.f) - log1pf(expf(-fabsf(x))); }

struct EpiF32 {
    static constexpr bool PERM = false, AFTER_DRAIN = false;
    float* C; int ldc;
    __device__ __forceinline__ void operator()(const f32x4 (&acc)[2][2][4][2], const Unit& u, int wr, int wc, int fr_in, int fq_in) const {
        int fr = fr_in, fq = fq_in; asm volatile("" : "+v"(fr), "+v"(fq));
        const int row0 = u.pm * BM + wr * 64 + fr, col0 = u.pn * BM + wc * 32 + 4 * fq;
#pragma unroll
        for (int ai = 0; ai < 2; ++ai)
#pragma unroll
            for (int m = 0; m < 4; ++m) { float* rowp = C + (size_t)(row0 + ai * HALF + m * 16) * ldc + col0;
#pragma unroll
                for (int bj = 0; bj < 2; ++bj)
#pragma unroll
                    for (int n = 0; n < 2; ++n) *(f32x4*)(rowp + bj * HALF + n * 16) = acc[ai][bj][m][n]; }
    }
};
template <int ACT, bool ROWSCALE> struct EpiBf16 {
    static constexpr bool PERM = true, AFTER_DRAIN = false;
    bf16_t* O; int ldc; const float* rs;
    __device__ __forceinline__ void operator()(const f32x4 (&acc)[2][2][4][2], const Unit& u, int wr, int wc, int fr_in, int fq_in) const {
        int fr = fr_in, fq = fq_in; asm volatile("" : "+v"(fr), "+v"(fq));
        const int row0 = u.pm * BM + wr * 64 + fr, col0 = u.pn * BM + wc * 32 + 8 * fq;
#pragma unroll
        for (int ai = 0; ai < 2; ++ai)
#pragma unroll
            for (int m = 0; m < 4; ++m) { const int row = row0 + ai * HALF + m * 16; bf16_t* rowp = O + (size_t)row * ldc + col0;
                float s = 1.f; if (ROWSCALE) s = rs[row];
#pragma unroll
                for (int bj = 0; bj < 2; ++bj) { f32x4 v0 = acc[ai][bj][m][0], v1 = acc[ai][bj][m][1];
                    if (ROWSCALE) { v0 = v0 * s; v1 = v1 * s; }
                    if (ACT == 1) {
#pragma unroll
                        for (int j = 0; j < 4; ++j) { const float a = fmaxf(v0[j], 0.f), b = fmaxf(v1[j], 0.f); v0[j] = a * a; v1[j] = b * b; } }
                    if (ACT == 2) { v0 = sigm4(v0); v1 = sigm4(v1); }
                    store8(rowp + bj * HALF, v0, v1); } }
    }
};
struct EpiInProj {
    static constexpr bool PERM = true, AFTER_DRAIN = false;
    unsigned char* ws; const float* gate_b;
    __device__ __forceinline__ void operator()(const f32x4 (&acc)[2][2][4][2], const Unit& u, int wr, int wc, int fr_in, int fq_in) const {
        int fr = fr_in, fq = fq_in; asm volatile("" : "+v"(fr), "+v"(fq));
        const int row0 = u.pm * BM + wr * 64 + fr, pn = u.pn, c8 = wc * 32 + 8 * fq;
        bf16_t* const QKpre = (bf16_t*)(ws + WS_QKPRE); bf16_t* const V = (bf16_t*)(ws + WS_V); bf16_t* const OGA = (bf16_t*)(ws + WS_OGA); bf16_t* const GB = (bf16_t*)(ws + WS_GB);
        bf16_t* const CQ = (bf16_t*)(ws + WS_CQ); bf16_t* const CKV = (bf16_t*)(ws + WS_CKV); bf16_t* const KPE = (bf16_t*)(ws + WS_KPE); float* const IF = (float*)(ws + WS_IF); const float* const rope = (const float*)(ws + WS_ROPE);
        if (pn < 8) {
            bf16_t* base = pn < 4 ? QKpre : V; const int col0 = (pn & 3) * 256 + c8;
#pragma unroll
            for (int ai = 0; ai < 2; ++ai)
#pragma unroll
                for (int m = 0; m < 4; ++m) { bf16_t* rowp = base + (size_t)(row0 + ai * HALF + m * 16) * 1024 + col0;
#pragma unroll
                    for (int bj = 0; bj < 2; ++bj) store8(rowp + bj * HALF, acc[ai][bj][m][0], acc[ai][bj][m][1]); }
        } else if (pn < 16) {
            const int col0 = (pn - 8) * 128 + c8;
#pragma unroll
            for (int ai = 0; ai < 2; ++ai)
#pragma unroll
                for (int m = 0; m < 4; ++m) { bf16_t* rowp = OGA + (size_t)(row0 + ai * HALF + m * 16) * 1024 + col0;
                    store8(rowp, sigm4(acc[ai][0][m][0]) * sigm4(acc[ai][1][m][0]), sigm4(acc[ai][0][m][1]) * sigm4(acc[ai][1][m][1])); }
        } else if (pn < 20) {
            const int col0 = (pn - 16) * 256 + c8;
#pragma unroll
            for (int ai = 0; ai < 2; ++ai)
#pragma unroll
                for (int m = 0; m < 4; ++m) { bf16_t* rowp = GB + (size_t)(row0 + ai * HALF + m * 16) * 1024 + col0;
#pragma unroll
                    for (int bj = 0; bj < 2; ++bj) store8(rowp + bj * HALF, sigm4(acc[ai][bj][m][0]), sigm4(acc[ai][bj][m][1])); }
        } else if (pn == 20) {
#pragma unroll
            for (int ai = 0; ai < 2; ++ai)
#pragma unroll
                for (int m = 0; m < 4; ++m) { bf16_t* rowp = CQ + (size_t)(row0 + ai * HALF + m * 16) * 384 + c8;
#pragma unroll
                    for (int bj = 0; bj < 2; ++bj) store8(rowp + bj * HALF, acc[ai][bj][m][0], acc[ai][bj][m][1]); }
        } else if (pn == 21) {
#pragma unroll
            for (int ai = 0; ai < 2; ++ai)
#pragma unroll
                for (int m = 0; m < 4; ++m) { const size_t row = (size_t)(row0 + ai * HALF + m * 16);
                    store8(CQ + row * 384 + 256 + c8, acc[ai][0][m][0], acc[ai][0][m][1]);
                    store8(CKV + row * 256 + c8, acc[ai][1][m][0], acc[ai][1][m][1]); }
        } else if (pn == 22) {
#pragma unroll
            for (int ai = 0; ai < 2; ++ai)
#pragma unroll
                for (int m = 0; m < 4; ++m) { const size_t row = (size_t)(row0 + ai * HALF + m * 16);
                    store8(CKV + row * 256 + 128 + c8, acc[ai][0][m][0], acc[ai][0][m][1]);
                    if (wc == 0 && fq == 0) {
                        const f32x4 gi = *(const f32x4*)gate_b, gf = *(const f32x4*)(gate_b + 4);
                        f32x4 iv = acc[ai][1][m][0] + gi, fv = acc[ai][1][m][1] + gf;
                        fv = (f32x4){logsigm(fv[0]), logsigm(fv[1]), logsigm(fv[2]), logsigm(fv[3])};
                        *(f32x4*)(IF + row * 8) = iv; *(f32x4*)(IF + row * 8 + 4) = fv; } }
        } else {
            if (wc == 0) {
#pragma unroll
                for (int ai = 0; ai < 2; ++ai)
#pragma unroll
                    for (int m = 0; m < 4; ++m) { const int row = row0 + ai * HALF + m * 16; const float* cs = rope + ((size_t)(row & 4095) * 32 + 8 * fq) * 2;
                        f32x4 o1[2], o2[2];
#pragma unroll
                        for (int n = 0; n < 2; ++n)
#pragma unroll
                            for (int j = 0; j < 4; ++j) { const float c = cs[(4 * n + j) * 2], s = cs[(4 * n + j) * 2 + 1], x1 = acc[ai][0][m][n][j], x2 = acc[ai][1][m][n][j];
                                o1[n][j] = x1 * c - x2 * s; o2[n][j] = x2 * c + x1 * s; }
                        store8(KPE + (size_t)row * 64 + 8 * fq, o1[0], o1[1]); store8(KPE + (size_t)row * 64 + 32 + 8 * fq, o2[0], o2[1]); asm volatile("" ::: "memory"); }
            }
        }
    }
};
struct EpiUpQ {
    static constexpr bool PERM = true, AFTER_DRAIN = false;
    unsigned char* ws; float qscale;
    __device__ __forceinline__ void operator()(const f32x4 (&acc)[2][2][4][2], const Unit& u, int wr, int wc, int fr_in, int fq_in) const {
        int fr = fr_in, fq = fq_in; asm volatile("" : "+v"(fr), "+v"(fq));
        const int row0 = u.pm * BM + wr * 64 + fr, pn = u.pn, c8 = wc * 32 + 8 * fq;
        bf16_t* const Qb = (bf16_t*)(ws + WS_QB); const float* const rs = (const float*)(ws + WS_RSTDQ); const float* const rope = (const float*)(ws + WS_ROPE);
        const int head = 4 * (pn - 4) + wc;
#pragma unroll
        for (int ai = 0; ai < 2; ++ai)
#pragma unroll
            for (int m = 0; m < 4; ++m) { const int row = row0 + ai * HALF + m * 16; const float sc = rs[row] * qscale;
                if (pn < 4) {
#pragma unroll
                    for (int bj = 0; bj < 2; ++bj) store8(Qb + (unsigned)row * 1536u + (2 * pn + bj) * 192 + c8, acc[ai][bj][m][0] * sc, acc[ai][bj][m][1] * sc);
                } else {
                    const f32x4* cs = (const f32x4*)(rope + (unsigned)((row & 4095) * 64 + 16 * fq));
                    f32x4 o1[2], o2[2];
#pragma unroll
                    for (int n = 0; n < 2; ++n) { const f32x4 ca = cs[2 * n], cb = cs[2 * n + 1];
                        const f32x4 x1 = acc[ai][0][m][n] * sc, x2 = acc[ai][1][m][n] * sc;
                        o1[n] = (f32x4){x1[0] * ca[0] - x2[0] * ca[1], x1[1] * ca[2] - x2[1] * ca[3], x1[2] * cb[0] - x2[2] * cb[1], x1[3] * cb[2] - x2[3] * cb[3]};
                        o2[n] = (f32x4){x2[0] * ca[0] + x1[0] * ca[1], x2[1] * ca[2] + x1[1] * ca[3], x2[2] * cb[0] + x1[2] * cb[1], x2[3] * cb[2] + x1[3] * cb[3]}; }
                    bf16_t* qp = Qb + (unsigned)row * 1536u + head * 192 + 128 + 8 * fq;
                    store8(qp, o1[0], o1[1]); store8(qp + 32, o2[0], o2[1]);
                }
                asm volatile("" ::: "memory"); }
    }
};

template <class Epi, class Sched, bool ALIGN_EPI = false, bool SP2 = false>
__device__ __forceinline__ void gemm_phase(PG8_LAS unsigned char* lds, const Gemm g, const Sched& S, const Epi& E, int wave_id) {
    int tid_ = (wave_id << 6) | (int)__builtin_amdgcn_mbcnt_hi(~0u, __builtin_amdgcn_mbcnt_lo(~0u, 0u)); asm volatile("" : "+v"(tid_));
    const int tid = tid_, wid = __builtin_amdgcn_readfirstlane(tid >> 6), lane = tid & 63, wr = wid >> 2, wc = wid & 3, fr = lane & 15, fq = lane >> 4;
    int K_ = g.K; asm volatile("" : "+s"(K_));
    const int K = K_, nt = K / BK;
    unsigned voffA[2], voffB[2];
#pragma unroll
    for (int i = 0; i < 2; ++i) { int R, C; stage_rc(tid * 16 + i * 8192, R, C); const int Rb = Epi::PERM ? ((R & ~31) + perm32(R & 31)) : R;
        voffA[i] = (unsigned)(R * K + C) * 2u; voffB[i] = (unsigned)(Rb * K + C) * 2u; }
    const size_t kstep = (size_t)(BK * 2);
    const size_t hstep = (size_t)HALF * K * 2;
    const size_t tstep = 2 * hstep;
    const unsigned ldsw = (unsigned)wid * 1024u;
    const int aoff = lds_byte(wr * 64 + fr, fq * 8), boff = lds_byte(wc * 32 + fr, fq * 8);
#define PG8_SA(b, h) (((b) * 2 + (h)) * HTB)
#define PG8_SB(b, h) ((4 + (b) * 2 + (h)) * HTB)
#define PG8_STAGE(bufoff, gbase, voff) do { _Pragma("unroll") for (int _i = 0; _i < 2; ++_i) \
        __builtin_amdgcn_global_load_lds((const unsigned*)((const char*)(gbase) + (voff)[_i]), (PG8_LAS unsigned*)(lds + (bufoff) + ldsw + _i * 8192), 16, 0, 0); } while (0)
#define PG8_LDA(dst, b, h) do { _Pragma("unroll") for (int m = 0; m < 4; ++m) _Pragma("unroll") for (int k = 0; k < 2; ++k) dst[m][k] = *(const PG8_LAS bf16x8*)(lds + PG8_SA(b, h) + aoff + m * 2048 + k * 1024); } while (0)
#define PG8_LDB(dst, b, h) do { _Pragma("unroll") for (int n = 0; n < 2; ++n) _Pragma("unroll") for (int k = 0; k < 2; ++k) dst[n][k] = *(const PG8_LAS bf16x8*)(lds + PG8_SB(b, h) + boff + n * 2048 + k * 1024); } while (0)
#define PG8_MMA(ai, bj, At, Bt) do { __builtin_amdgcn_s_setprio(1); _Pragma("unroll") for (int m = 0; m < 4; ++m) _Pragma("unroll") for (int n = 0; n < 2; ++n) _Pragma("unroll") for (int k = 0; k < 2; ++k) \
        acc[ai][bj][m][n] = __builtin_amdgcn_mfma_f32_16x16x32_bf16(Bt[n][k], At[m][k], acc[ai][bj][m][n], 0, 0, 0); __builtin_amdgcn_s_setprio(0); } while (0)
#define PG8_WAIT_V(n) asm volatile("s_waitcnt vmcnt(" #n ")" ::: "memory")
#define PG8_WAIT_L(n) asm volatile("s_waitcnt lgkmcnt(" #n ")" ::: "memory")
#define PG8_BAR __builtin_amdgcn_s_barrier()
#define PG8_SCHED __builtin_amdgcn_sched_barrier(0)
    Unit cur, nxt; int ui = 0;
    if (!S.next(0, cur)) return;
    f32x4 acc[2][2][4][2];
#pragma unroll
    for (int a = 0; a < 2; ++a)
#pragma unroll
        for (int b = 0; b < 2; ++b)
#pragma unroll
            for (int m = 0; m < 4; ++m)
#pragma unroll
                for (int n = 0; n < 2; ++n) acc[a][b][m][n] = (f32x4){0.f, 0.f, 0.f, 0.f};
    bf16x8 At[4][2], B0[2][2], B1[2][2];
    const char* cA = (const char*)g.A + (size_t)cur.pm * tstep; const char* cB = (const char*)g.Bt + (size_t)cur.pn * tstep;
    S.a_ready(cur);
    if constexpr (SP2) {
        PG8_STAGE(PG8_SB(0, 0), cB, voffB); PG8_STAGE(PG8_SB(0, 1), cB + hstep, voffB); PG8_STAGE(PG8_SA(0, 0), cA, voffA); PG8_STAGE(PG8_SA(0, 1), cA + hstep, voffA);
        if (wr == 1) PG8_BAR;
        PG8_WAIT_V(2); PG8_BAR;
        PG8_STAGE(PG8_SB(1, 0), cB + kstep, voffB); PG8_STAGE(PG8_SA(1, 0), cA + kstep, voffA); PG8_STAGE(PG8_SB(1, 1), cB + hstep + kstep, voffB);
        PG8_WAIT_V(6); PG8_BAR;
    } else {
        PG8_STAGE(PG8_SB(0, 0), cB, voffB); PG8_STAGE(PG8_SA(0, 0), cA, voffA); PG8_STAGE(PG8_SB(0, 1), cB + hstep, voffB); PG8_STAGE(PG8_SA(0, 1), cA + hstep, voffA);
        if (wr == 1) PG8_BAR;
        PG8_WAIT_V(4); PG8_BAR;
        PG8_STAGE(PG8_SB(1, 0), cB + kstep, voffB); PG8_STAGE(PG8_SA(1, 0), cA + kstep, voffA); PG8_STAGE(PG8_SB(1, 1), cB + hstep + kstep, voffB);
        PG8_WAIT_V(6); PG8_BAR;
    }
    for (;;) {
        const bool has_next = S.next(ui + 1, nxt);
        const char* nA = has_next ? (const char*)g.A + (size_t)nxt.pm * tstep : cA; const char* nB = has_next ? (const char*)g.Bt + (size_t)nxt.pn * tstep : cB;
        for (int t = 0; t < nt; t += 2) {
            const bool last = (t == nt - 2);
            const char* a1 = cA + (size_t)(t + 1) * kstep;
            const char* a2 = last ? nA : cA + (size_t)(t + 2) * kstep; const char* b2 = last ? nB : cB + (size_t)(t + 2) * kstep;
            const char* a3 = a2 + kstep; const char* b3 = b2 + kstep;
            if (last && has_next) S.a_ready(nxt);
            if constexpr (SP2) {
            PG8_LDB(B0, 0, 0); PG8_LDB(B1, 0, 1); PG8_SCHED; PG8_LDA(At, 0, 0); PG8_STAGE(PG8_SA(1, 1), a1 + hstep, voffA);
            PG8_WAIT_V(8); PG8_WAIT_L(0); PG8_BAR; PG8_MMA(0, 0, At, B0); PG8_MMA(0, 1, At, B1); PG8_BAR; PG8_SCHED;
            PG8_LDA(At, 0, 1); PG8_STAGE(PG8_SB(0, 0), b2, voffB); PG8_STAGE(PG8_SB(0, 1), b2 + hstep, voffB); PG8_STAGE(PG8_SA(0, 0), a2, voffA);
            PG8_WAIT_V(8); PG8_WAIT_L(0); PG8_BAR; PG8_MMA(1, 0, At, B0); PG8_MMA(1, 1, At, B1); PG8_BAR; PG8_SCHED;
            PG8_LDB(B0, 1, 0); PG8_LDB(B1, 1, 1); PG8_SCHED; PG8_LDA(At, 1, 0); PG8_STAGE(PG8_SA(0, 1), a2 + hstep, voffA);
            PG8_WAIT_V(8); PG8_WAIT_L(0); PG8_BAR; PG8_MMA(0, 0, At, B0); PG8_MMA(0, 1, At, B1); PG8_BAR; PG8_SCHED;
            PG8_LDA(At, 1, 1); PG8_STAGE(PG8_SB(1, 0), b3, voffB); PG8_STAGE(PG8_SB(1, 1), b3 + hstep, voffB); PG8_STAGE(PG8_SA(1, 0), a3, voffA);
            PG8_WAIT_V(8); PG8_WAIT_L(0); PG8_BAR; PG8_MMA(1, 0, At, B0); PG8_MMA(1, 1, At, B1); PG8_BAR; PG8_SCHED;
            } else {
            PG8_LDB(B0, 0, 0); PG8_SCHED; PG8_LDA(At, 0, 0); PG8_STAGE(PG8_SA(1, 1), a1 + hstep, voffA);
            PG8_WAIT_L(8); PG8_BAR; PG8_WAIT_L(0); PG8_MMA(0, 0, At, B0); PG8_BAR; PG8_SCHED;
            PG8_LDB(B1, 0, 1); PG8_STAGE(PG8_SB(0, 0), b2, voffB);
            PG8_BAR; PG8_WAIT_L(0); PG8_MMA(0, 1, At, B1); PG8_BAR;
            PG8_LDA(At, 0, 1); PG8_STAGE(PG8_SA(0, 0), a2, voffA);
            PG8_BAR; PG8_WAIT_L(0); PG8_MMA(1, 0, At, B0); PG8_BAR; PG8_SCHED;
            PG8_STAGE(PG8_SB(0, 1), b2 + hstep, voffB);
            PG8_WAIT_V(6); PG8_BAR; PG8_MMA(1, 1, At, B1); PG8_BAR;
            PG8_LDB(B0, 1, 0); PG8_SCHED; PG8_LDA(At, 1, 0); PG8_STAGE(PG8_SA(0, 1), a2 + hstep, voffA);
            PG8_WAIT_L(8); PG8_BAR; PG8_WAIT_L(0); PG8_MMA(0, 0, At, B0); PG8_BAR; PG8_SCHED;
            PG8_LDB(B1, 1, 1); PG8_STAGE(PG8_SB(1, 0), b3, voffB);
            PG8_BAR; PG8_WAIT_L(0); PG8_MMA(0, 1, At, B1); PG8_BAR;
            PG8_LDA(At, 1, 1); PG8_STAGE(PG8_SA(1, 0), a3, voffA);
            PG8_BAR; PG8_WAIT_L(0); PG8_MMA(1, 0, At, B0); PG8_BAR; PG8_SCHED;
            PG8_STAGE(PG8_SB(1, 1), b3 + hstep, voffB);
            PG8_WAIT_V(6); PG8_BAR; PG8_MMA(1, 1, At, B1); PG8_BAR;
            }
        }
        if constexpr (ALIGN_EPI) { if (wr == 0) PG8_BAR; }
        if constexpr (!Epi::AFTER_DRAIN) { E(acc, cur, wr, wc, fr, fq); S.done(cur); }
        if (!has_next) break;
#pragma unroll
        for (int a = 0; a < 2; ++a)
#pragma unroll
            for (int b = 0; b < 2; ++b)
#pragma unroll
                for (int m = 0; m < 4; ++m)
#pragma unroll
                    for (int n = 0; n < 2; ++n) acc[a][b][m][n] = (f32x4){0.f, 0.f, 0.f, 0.f};
        cur = nxt; cA = nA; cB = nB; ++ui;
        if constexpr (ALIGN_EPI) { if (wr == 1) PG8_BAR; }
    }
    PG8_WAIT_V(0);
    if constexpr (!ALIGN_EPI) { if (wr == 0) PG8_BAR; }
    PG8_BAR;
    if constexpr (Epi::AFTER_DRAIN) { E.fused(acc, cur, wr, wc, fr, fq, lds, wid, lane); S.done(cur); }
#undef PG8_SA
#undef PG8_SB
#undef PG8_STAGE
#undef PG8_LDA
#undef PG8_LDB
#undef PG8_MMA
#undef PG8_WAIT_V
#undef PG8_WAIT_L
#undef PG8_BAR
#undef PG8_SCHED
}
}
#define XB_TMO      128
#define XB_XCNT(j)  (256  + 64 * (j))
#define XB_XSUB(j)  (1280 + 64 * (j))
#define XB_XGEN(j)  (2304 + 64 * (j))
#define XB_TOP      3328
#define XB_TOPGEN   3392
#define XCD_BAR_WORDS 3456
#define XB_SPIN_CAP (1u << 22)

__device__ __forceinline__ unsigned xb_ld(unsigned* p)              { return __hip_atomic_load(p, __ATOMIC_RELAXED, __HIP_MEMORY_SCOPE_AGENT); }
__device__ __forceinline__ unsigned xb_add(unsigned* p, unsigned v) { return __hip_atomic_fetch_add(p, v, __ATOMIC_RELAXED, __HIP_MEMORY_SCOPE_AGENT); }
__device__ __forceinline__ unsigned xb_xcc_id() { return (unsigned)__builtin_amdgcn_s_getreg((3 << 11) | 20) & 0xFu; }
#define XB_SPIN(cond, bar) do { unsigned _sp = 0; while (cond) { __builtin_amdgcn_s_sleep(1); \
    if ((++_sp & 255u) == 0u) { if (xb_ld(&(bar)[XB_TMO])) break; if (_sp > XB_SPIN_CAP) { atomicAdd(&(bar)[XB_TMO], 1u); break; } } } } while (0)

struct XcdBarrier {
    unsigned* bar; unsigned x;
    volatile LAS unsigned* st;
};

__device__ __forceinline__ XcdBarrier xcd_barrier_post(unsigned* bar, volatile LAS unsigned* st) {
    XcdBarrier b; b.bar = bar; b.x = xb_xcc_id(); b.st = st;
    if (threadIdx.x == 0) (void)xb_add(&bar[XB_XCNT(b.x)], 1u);
    return b;
}
__device__ __forceinline__ void xcd_barrier_complete(unsigned* bar, unsigned x, unsigned& nloc, unsigned& nx) {
    const unsigned G = gridDim.x * gridDim.y * gridDim.z;
    unsigned sum, cnt, mine, sp = 0u;
    for (;;) {
        sum = 0u; cnt = 0u; mine = 0u;
#pragma unroll
        for (unsigned j = 0; j < 16; ++j) { const unsigned c = xb_ld(&bar[XB_XCNT(j)]); sum += c; cnt += (c > 0u) ? 1u : 0u; mine = (j == x) ? c : mine; }
        if (sum == G) break;
        __builtin_amdgcn_s_sleep(1);
        if ((++sp & 255u) == 0u) { if (xb_ld(&bar[XB_TMO])) break; if (sp > XB_SPIN_CAP) { atomicAdd(&bar[XB_TMO], 1u); break; } }
    }
    nloc = mine > 0u ? mine : 1u; nx = cnt > 0u ? cnt : 1u;
}

__device__ __forceinline__ void xcd_barrier(const XcdBarrier& b) {
    asm volatile("s_waitcnt vmcnt(0)" ::: "memory");
    __syncthreads();
    if (threadIdx.x == 0) {
        unsigned* bar = b.bar;
        __builtin_amdgcn_s_waitcnt(0);
        unsigned nloc = b.st[0], nx = b.st[1];
        if (nloc == 0u) { xcd_barrier_complete(bar, b.x, nloc, nx); b.st[0] = nloc; b.st[1] = nx; }
        const unsigned old = xb_add(&bar[XB_XSUB(b.x)], 1u);
        const unsigned gen = old / nloc;
        if (old + 1u == (gen + 1u) * nloc) {
            __builtin_amdgcn_fence(__ATOMIC_RELEASE, "agent");
            asm volatile("s_waitcnt vmcnt(0)" ::: "memory");
            const unsigned og = xb_add(&bar[XB_TOP], 1u);
            const unsigned tg = og / nx;
            if (og + 1u == (tg + 1u) * nx) xb_add(&bar[XB_TOPGEN], 1u);
            else XB_SPIN(xb_ld(&bar[XB_TOPGEN]) == tg, bar);
            __builtin_amdgcn_fence(__ATOMIC_ACQUIRE, "agent");
            xb_add(&bar[XB_XGEN(b.x)], 1u);
            asm volatile("s_waitcnt vmcnt(0)" ::: "memory");
        } else {
            XB_SPIN(xb_ld(&bar[XB_XGEN(b.x)]) == gen, bar);
            __builtin_amdgcn_fence(__ATOMIC_ACQUIRE, "agent");
            asm volatile("s_waitcnt vmcnt(0)" ::: "memory");
        }
    }
    __syncthreads();
}
__device__ __forceinline__ int in_map(int p) {
    if (p < 2048) return p;
    if (p < 4096) { const int t = (p - 2048) >> 8, r = (p - 2048) & 255; return r < 128 ? 2048 + 128 * t + r : 3784 + 128 * t + (r - 128); }
    if (p < 5120) return 4808 + (p - 4096);
    if (p < 5376) return 3080 + (p - 5120);
    if (p < 5632) { const int r = p - 5376; return r < 128 ? 3336 + r : 3464 + (r - 128); }
    if (p < 5888) { const int r = p - 5632; if (r < 128) return 3592 + r; const int rr = r - 128; return rr < 8 ? 3072 + rr : -1; }
    { const int r = p - 5888; if (r < 32) return 3720 + r; if (r >= 128 && r < 160) return 3752 + (r - 128); return -1; }
}
__device__ __forceinline__ int uq_map(int p) {
    if (p < 1024) return (p >> 7) * 192 + (p & 127);
    const int t = (p - 1024) >> 8, r = (p - 1024) & 255, bj = r >> 7, wc = (r & 127) >> 5, i = r & 31;
    return (4 * t + wc) * 192 + 128 + 32 * bj + i;
}
template <int MAP> __device__ __forceinline__ int col_map(int p) { if (MAP == 1) return in_map(p); if (MAP == 2) return uq_map(p); return p; }
template <int MAP> __device__ __forceinline__ void p0_transpose_item(const float* W, int K, int N, int NP, bf16* WT, const float* kscale, LAS float* scr, int item, int lane) {
    const int nblk = NP / 32, kb = item / nblk, nb = item % nblk, k0 = 64 * kb, n0 = 32 * nb;
    const int L = col_map<MAP>(n0 + (lane & 31));
#pragma unroll 8
    for (int i = 0; i < 32; ++i) { const int kk = 2 * i + (lane >> 5); float v = 0.f;
        if (L >= 0) { v = W[(size_t)(k0 + kk) * N + L]; if (kscale) v *= kscale[k0 + kk]; }
        scr[kk * 33 + (lane & 31)] = v; }
    LDS_WAIT(); asm volatile("" ::: "memory");
    const int c = lane & 7;
#pragma unroll
    for (int j = 0; j < 4; ++j) { const int n = (lane >> 3) + 8 * j; const LAS float* s = scr + (8 * c) * 33 + n;
        v4u o; o.x = pk2(s[0 * 33], s[1 * 33]); o.y = pk2(s[2 * 33], s[3 * 33]); o.z = pk2(s[4 * 33], s[5 * 33]); o.w = pk2(s[6 * 33], s[7 * 33]);
        *(GAS v4u*)(WT + (size_t)(n0 + n) * K + k0 + 8 * c) = o; }
    LDS_WAIT(); asm volatile("" ::: "memory");
}
struct P0Args { const float *c, *w_ada, *b_ada, *w_in, *w_uq, *w_ukv, *w_out, *w_ff1, *w_ff2, *qn, *kvn; float* mod; float* rope; bf16 *WIN, *WUQ, *WUKV, *WOUT, *WFF1, *WFF2; };
__device__ __forceinline__ void p0_prologue(const P0Args& a, LAS unsigned char* lds, int tid, int lane, int wave, int G) {
    {
        LAS float* sc = (LAS float*)lds;
        LAS float* red = (LAS float*)(lds + 16384);
        for (int i = tid; i < 4096; i += NTHREADS) { const float v = a.c[i]; sc[i] = v / (1.0f + expf(-v)); }
        __syncthreads();
        for (int it = blockIdx.x; it < NMODC / 32; it += G) {
            const int half = lane >> 5, cl = lane & 31, col = it * 32 + cl, ksl = wave * 2 + half;
            float a0 = 0.f, a1 = 0.f, a2 = 0.f, a3 = 0.f;
#pragma unroll 16
            for (int k = 64 * ksl; k < 64 * ksl + 64; ++k) { const float w = a.w_ada[(size_t)k * NMODC + col];
                a0 += sc[k] * w; a1 += sc[1024 + k] * w; a2 += sc[2048 + k] * w; a3 += sc[3072 + k] * w; }
            red[(ksl * 4 + 0) * 32 + cl] = a0; red[(ksl * 4 + 1) * 32 + cl] = a1; red[(ksl * 4 + 2) * 32 + cl] = a2; red[(ksl * 4 + 3) * 32 + cl] = a3;
            __syncthreads();
            if (tid < 128) { const int b = tid >> 5, c2 = tid & 31; float s = a.b_ada[it * 32 + c2];
                for (int k = 0; k < 16; ++k) s += red[(k * 4 + b) * 32 + c2];
                a.mod[b * NMODC + it * 32 + c2] = s; }
            __syncthreads();
        }
        __syncthreads();
    }
    for (int idx = blockIdx.x * NTHREADS + tid; idx < SEQ * 32; idx += G * NTHREADS) {
        const int pos = idx >> 5, i = idx & 31; const float inv = powf(10000.0f, -(float)i / 32.0f); const float ang = (float)pos * inv;
        float s, c; sincosf(ang, &s, &c); a.rope[idx * 2] = c; a.rope[idx * 2 + 1] = s; }
    LAS float* scr = (LAS float*)(lds + wave * 16384);
    const int gw = blockIdx.x * NWAVES + wave, NGW = G * NWAVES;
    constexpr int I_IN = (DM / 64) * (NIN / 32), I_UQ = (QRANK / 64) * (NQ / 32), I_UKV = (KVRANK / 64) * (NKV / 32), I_OUT = (DM / 64) * (DM / 32), I_F1 = (DM / 64) * (DFF / 32), I_F2 = (DFF / 64) * (DM / 32);
    constexpr int NITEMS = I_IN + I_UQ + I_UKV + I_OUT + I_F1 + I_F2;
    for (int it = gw; it < NITEMS; it += NGW) {
        int r = it;
        if (r < I_IN) { p0_transpose_item<1>(a.w_in, DM, DIN, NIN, a.WIN, nullptr, scr, r, lane); continue; } r -= I_IN;
        if (r < I_UQ) { p0_transpose_item<2>(a.w_uq, QRANK, NQ, NQ, a.WUQ, a.qn, scr, r, lane); continue; } r -= I_UQ;
        if (r < I_UKV) { p0_transpose_item<0>(a.w_ukv, KVRANK, NKV, NKV, a.WUKV, a.kvn, scr, r, lane); continue; } r -= I_UKV;
        if (r < I_OUT) { p0_transpose_item<0>(a.w_out, DM, DM, DM, a.WOUT, nullptr, scr, r, lane); continue; } r -= I_OUT;
        if (r < I_F1) { p0_transpose_item<0>(a.w_ff1, DM, DFF, DFF, a.WFF1, nullptr, scr, r, lane); continue; } r -= I_F1;
        p0_transpose_item<0>(a.w_ff2, DFF, DM, DM, a.WFF2, nullptr, scr, r, lane);
    }
}

__device__ __forceinline__ void p1_rows(const float* x, const float* nw, const float* mod, bf16* H, int lane, int gw, int NGW) {
    for (int m = gw; m < M; m += NGW) {
        const int b = m >> 12; const GAS f32x4* xr = (const GAS f32x4*)(x + (size_t)m * DM) + lane;
        f32x4 v[4]; float s = 0.f;
#pragma unroll
        for (int j = 0; j < 4; ++j) { v[j] = xr[64 * j]; s += (v[j].x * v[j].x + v[j].y * v[j].y) + (v[j].z * v[j].z + v[j].w * v[j].w); }
        const float rstd = 1.0f / sqrtf(wave_sum(s) * (1.f / DM) + EPS);
        GAS v2u* o = (GAS v2u*)(H + (size_t)m * DM) + lane;
#pragma unroll
        for (int j = 0; j < 4; ++j) { const int c = 4 * (lane + 64 * j);
            const f32x4 w = *(const f32x4*)(nw + c), sh = *(const f32x4*)(mod + b * NMODC + c), sc = *(const f32x4*)(mod + b * NMODC + DM + c);
            const f32x4 h = v[j] * rstd * w * (sc + 1.0f) + sh;
            v2u p; p.x = pk2(h.x, h.y); p.y = pk2(h.z, h.w); o[64 * j] = p; }
    }
}
__device__ __forceinline__ void p10_rows(const float* x, const float* y1, const float* w_post, const float* w_pre, const float* mod, float* out, bf16* H2, int lane, int gw, int NGW) {
    for (int m = gw; m < M; m += NGW) {
        const int b = m >> 12; const GAS f32x4* yr = (const GAS f32x4*)(y1 + (size_t)m * DM) + lane; const GAS f32x4* xr = (const GAS f32x4*)(x + (size_t)m * DM) + lane;
        f32x4 v[4]; float s = 0.f;
#pragma unroll
        for (int j = 0; j < 4; ++j) { v[j] = yr[64 * j]; s += (v[j].x * v[j].x + v[j].y * v[j].y) + (v[j].z * v[j].z + v[j].w * v[j].w); }
        const float rstd = 1.0f / sqrtf(wave_sum(s) * (1.f / DM) + EPS);
        float s2 = 0.f;
        GAS f32x4* orow = (GAS f32x4*)(out + (size_t)m * DM) + lane;
#pragma unroll
        for (int j = 0; j < 4; ++j) { const int c = 4 * (lane + 64 * j);
            const f32x4 w = *(const f32x4*)(w_post + c), gt = *(const f32x4*)(mod + b * NMODC + 2 * DM + c);
            v[j] = xr[64 * j] + gt * (v[j] * rstd * w);
            orow[64 * j] = v[j];
            s2 += (v[j].x * v[j].x + v[j].y * v[j].y) + (v[j].z * v[j].z + v[j].w * v[j].w); }
        const float rstd2 = 1.0f / sqrtf(wave_sum(s2) * (1.f / DM) + EPS);
        GAS v2u* o = (GAS v2u*)(H2 + (size_t)m * DM) + lane;
#pragma unroll
        for (int j = 0; j < 4; ++j) { const int c = 4 * (lane + 64 * j);
            const f32x4 w = *(const f32x4*)(w_pre + c), sh = *(const f32x4*)(mod + b * NMODC + 3 * DM + c), sc = *(const f32x4*)(mod + b * NMODC + 4 * DM + c);
            const f32x4 h = v[j] * rstd2 * w * (sc + 1.0f) + sh;
            v2u p; p.x = pk2(h.x, h.y); p.y = pk2(h.z, h.w); o[64 * j] = p; }
    }
}
__device__ __forceinline__ void p13_rows(const float* y2, const float* w_post, const float* mod, float* out, int lane, int gw, int NGW) {
    for (int m = gw; m < M; m += NGW) {
        const int b = m >> 12; const GAS f32x4* yr = (const GAS f32x4*)(y2 + (size_t)m * DM) + lane;
        f32x4 v[4]; float s = 0.f;
#pragma unroll
        for (int j = 0; j < 4; ++j) { v[j] = yr[64 * j]; s += (v[j].x * v[j].x + v[j].y * v[j].y) + (v[j].z * v[j].z + v[j].w * v[j].w); }
        const float rstd = 1.0f / sqrtf(wave_sum(s) * (1.f / DM) + EPS);
        GAS f32x4* orow = (GAS f32x4*)(out + (size_t)m * DM) + lane;
#pragma unroll
        for (int j = 0; j < 4; ++j) { const int c = 4 * (lane + 64 * j);
            const f32x4 w = *(const f32x4*)(w_post + c), gt = *(const f32x4*)(mod + b * NMODC + 5 * DM + c);
            orow[64 * j] = orow[64 * j] + gt * (v[j] * rstd * w); }
    }
}
__device__ __forceinline__ void unpack8(v4u w, float* f) { f[0] = bflo(w.x); f[1] = bfhi(w.x); f[2] = bflo(w.y); f[3] = bfhi(w.y); f[4] = bflo(w.z); f[5] = bfhi(w.z); f[6] = bflo(w.w); f[7] = bfhi(w.w); }
__device__ __forceinline__ void p3_conv(const bf16* QKpre, const float* cw, const float* cb, bf16* Qc, bf16* Kc, const bf16* CQ, const bf16* CKV, float* rstdq, float* rstdkv, int tid, int lane, int wave, int G) {
    for (int item = blockIdx.x * NTHREADS + tid; item < (M / 16) * 128; item += G * NTHREADS) {
        const int rb = item >> 7, ch = item & 127, c0 = 8 * ch, row0 = 16 * rb, s0 = row0 & (SEQ - 1);
        float w[4][8], bias[8], xw[4][8];
#pragma unroll
        for (int j = 0; j < 4; ++j)
#pragma unroll
            for (int e = 0; e < 8; ++e) w[j][e] = cw[j * 1024 + c0 + e];
#pragma unroll
        for (int e = 0; e < 8; ++e) bias[e] = cb[c0 + e];
#pragma unroll
        for (int j = 0; j < 3; ++j) {
            if (s0 == 0) {
#pragma unroll
                for (int e = 0; e < 8; ++e) xw[j][e] = 0.f;
            } else unpack8(*(const GAS v4u*)(QKpre + (size_t)(row0 - 3 + j) * 1024 + c0), xw[j]);
        }
        const float osc = c0 >= 512 ? 0.08838834764831845f : 1.0f;
        bf16* dst = c0 >= 512 ? Kc + (c0 - 512) : Qc + c0;
#pragma unroll 4
        for (int r = 0; r < 16; ++r) {
            unpack8(*(const GAS v4u*)(QKpre + (size_t)(row0 + r) * 1024 + c0), xw[3]);
            float y[8];
#pragma unroll
            for (int e = 0; e < 8; ++e) { const float t = w[0][e] * xw[0][e] + w[1][e] * xw[1][e] + w[2][e] * xw[2][e] + w[3][e] * xw[3][e] + bias[e];
                y[e] = t / (1.0f + __expf(-t)) * osc; }
            v4u o; o.x = pk2(y[0], y[1]); o.y = pk2(y[2], y[3]); o.z = pk2(y[4], y[5]); o.w = pk2(y[6], y[7]);
            *(GAS v4u*)(dst + (size_t)(row0 + r) * 512) = o;
#pragma unroll
            for (int e = 0; e < 8; ++e) { xw[0][e] = xw[1][e]; xw[1][e] = xw[2][e]; xw[2][e] = xw[3][e]; }
        }
    }
    const int gw = blockIdx.x * NWAVES + wave, NGW = G * NWAVES;
    for (int m = gw; m < M; m += NGW) {
        const GAS unsigned* q = (const GAS unsigned*)(CQ + (size_t)m * QRANK); const GAS unsigned* k = (const GAS unsigned*)(CKV + (size_t)m * KVRANK);
        float sq = 0.f, sk = 0.f;
#pragma unroll
        for (int i = 0; i < 3; ++i) { const unsigned w = q[lane + 64 * i]; const float a = bflo(w), b = bfhi(w); sq += a * a + b * b; }
#pragma unroll
        for (int i = 0; i < 2; ++i) { const unsigned w = k[lane + 64 * i]; const float a = bflo(w), b = bfhi(w); sk += a * a + b * b; }
        sq = wave_sum(sq); sk = wave_sum(sk);
        if (lane == 0) { rstdq[m] = 1.0f / sqrtf(sq * (1.f / QRANK) + EPS); rstdkv[m] = 1.0f / sqrtf(sk * (1.f / KVRANK) + EPS); }
    }
}
__device__ __forceinline__ void mlstm_naive(const bf16* Qc, const bf16* Kc, const bf16* V, const float* IF, const bf16* OGA, const float* hnw, bf16* Y, LAS unsigned char* lds, int tid, int lane, int wave, int G) {
    LAS bf16* qs = (LAS bf16*)lds; LAS bf16* ks = (LAS bf16*)(lds + 16384); LAS bf16* vs = (LAS bf16*)(lds + 32768);
    LAS float* gi = (LAS float*)(lds + 65536); LAS float* gf = gi + 64; LAS float* red = gi + 128;
    for (int bh = blockIdx.x; bh < 16; bh += G) {
        const int b = bh >> 2, h = bh & 3, v = tid >> 1, dh = tid & 1;
        float C[64], n[64]; float m = 0.f;
#pragma unroll
        for (int d = 0; d < 64; ++d) { C[d] = 0.f; n[d] = 0.f; }
        const float hw = hnw[h * 256 + v];
        for (int c = 0; c < 64; ++c) {
            const size_t rowbase = (size_t)b * SEQ + 64 * c;
            __syncthreads();
            for (int i = tid; i < 1024; i += NTHREADS) { const int r = i >> 4, ch = i & 15;
                *(LAS v4u*)(qs + r * 128 + ch * 8) = *(const GAS v4u*)(Qc + (rowbase + r) * 512 + h * 128 + ch * 8);
                *(LAS v4u*)(ks + r * 128 + ch * 8) = *(const GAS v4u*)(Kc + (rowbase + r) * 512 + h * 128 + ch * 8); }
            for (int i = tid; i < 2048; i += NTHREADS) { const int r = i >> 5, ch = i & 31;
                *(LAS v4u*)(vs + r * 256 + ch * 8) = *(const GAS v4u*)(V + (rowbase + r) * 1024 + h * 256 + ch * 8); }
            if (tid < 64) { gi[tid] = IF[(rowbase + tid) * 8 + h]; gf[tid] = IF[(rowbase + tid) * 8 + 4 + h]; }
            __syncthreads();
            for (int t = 0; t < 64; ++t) {
                const float it = gi[t], lf = gf[t];
                const float mn = fmaxf(lf + m, it), fg = expf(lf + m - mn), ig = expf(it - mn); m = mn;
                const float vv = bf2f(vs[t * 256 + v]) * ig;
                float num = 0.f, den = 0.f;
#pragma unroll
                for (int d8 = 0; d8 < 8; ++d8) {
                    float kf[8], qf[8];
                    unpack8(*(const LAS v4u*)(ks + t * 128 + 64 * dh + 8 * d8), kf); unpack8(*(const LAS v4u*)(qs + t * 128 + 64 * dh + 8 * d8), qf);
#pragma unroll
                    for (int e = 0; e < 8; ++e) { const int d = 8 * d8 + e; C[d] = fg * C[d] + vv * kf[e]; n[d] = fg * n[d] + ig * kf[e]; num += C[d] * qf[e]; den += n[d] * qf[e]; }
                }
                num += __shfl_xor(num, 1); den += __shfl_xor(den, 1);
                const float hv = num / fmaxf(fabsf(den), expf(-m));
                float s = dh == 0 ? hv * hv : 0.f; s = wave_sum(s);
                if (lane == 0) red[(t & 1) * 8 + wave] = s;
                __syncthreads();
                float tot = 0.f;
#pragma unroll
                for (int w = 0; w < 8; ++w) tot += red[(t & 1) * 8 + w];
                const float rms = 1.0f / sqrtf(tot * (1.f / 256.f) + EPS);
                if (dh == 0) { const size_t o = (rowbase + t) * 1024 + h * 256 + v; Y[o] = (bf16)f2bf(hv * rms * hw * bf2f(OGA[o])); }
            }
        }
    }
}
__device__ __forceinline__ void attn_naive(const bf16* Qb, const bf16* KVb, const bf16* KPE, const bf16* GB, bf16* Y, LAS unsigned char* lds, int lane, int wave, int G) {
    LAS bf16* qs = (LAS bf16*)(lds + wave * 512);
    const int gw = blockIdx.x * NWAVES + wave, NGW = G * NWAVES;
    for (int item = gw; item < BATCH * 8 * SEQ; item += NGW) {
        const int s = item & (SEQ - 1), h = (item >> 12) & 7, b = item >> 15; const size_t row = (size_t)b * SEQ + s;
        if (lane < 24) *(LAS v4u*)(qs + lane * 8) = *(const GAS v4u*)(Qb + row * 1536 + h * 192 + lane * 8);
        LDS_WAIT(); asm volatile("" ::: "memory");
        float m = -1e30f, l = 0.f, o0 = 0.f, o1 = 0.f;
        for (int kb = 0; kb <= (s >> 6); ++kb) {
            const int key = 64 * kb + lane; const size_t krow = (size_t)b * SEQ + key;
            float sc = 0.f;
#pragma unroll 4
            for (int c = 0; c < 24; ++c) {
                float kf[8], qf[8];
                const v4u kw = c < 16 ? *(const GAS v4u*)(KVb + krow * 2048 + h * 256 + c * 8) : *(const GAS v4u*)(KPE + krow * 64 + (c - 16) * 8);
                unpack8(kw, kf); unpack8(*(const LAS v4u*)(qs + c * 8), qf);
#pragma unroll
                for (int e = 0; e < 8; ++e) sc += kf[e] * qf[e];
            }
            if (key > s) sc = -__builtin_inff();
            const float mn = fmaxf(m, wave_max(sc)), alpha = exp2f(m - mn), p = exp2f(sc - mn);
            l = l * alpha + wave_sum(p); o0 *= alpha; o1 *= alpha; m = mn;
            for (int j = 0; j < 64; ++j) { const float pj = __shfl(p, j);
                const unsigned vw = *(const GAS unsigned*)(KVb + ((size_t)b * SEQ + 64 * kb + j) * 2048 + h * 256 + 128 + 2 * lane);
                o0 += pj * bflo(vw); o1 += pj * bfhi(vw); }
        }
        const size_t oi = row * 1024 + h * 128 + 2 * lane;
        const unsigned yw = *(const GAS unsigned*)(Y + oi), gw2 = *(const GAS unsigned*)(GB + oi);
        const float r0 = bflo(yw) + bflo(gw2) * (o0 / l), r1 = bfhi(yw) + bfhi(gw2) * (o1 / l);
        *(GAS unsigned*)(Y + oi) = pk2(r0, r1);
        LDS_WAIT(); asm volatile("" ::: "memory");
    }
}
namespace attn {
constexpr int KS = 400, VS = 320;
constexpr int KB_BYTES = 64 * KS, VB_BYTES = 64 * VS;
constexpr int K_OFF = 0, V_OFF = 2 * KB_BYTES;
constexpr int OS = 272;
__device__ __forceinline__ int crow(int r, int hi) { return (r & 3) + 8 * (r >> 2) + 4 * hi; }
typedef float f32x2_t __attribute__((ext_vector_type(2))); typedef __bf16 bf16x2_t __attribute__((ext_vector_type(2)));
__device__ __forceinline__ unsigned cvtpk(float lo, float hi) { f32x2_t v = {lo, hi}; bf16x2_t b = __builtin_convertvector(v, bf16x2_t); return __builtin_bit_cast(unsigned, b); }
typedef short v4i16_t __attribute__((ext_vector_type(4)));
__device__ __forceinline__ s16x4 vtr(const LAS unsigned char* p) { return __builtin_bit_cast(s16x4, __builtin_amdgcn_ds_read_tr16_b64_v4i16((LAS v4i16_t*)p)); }
__device__ __forceinline__ float swapmax(float v) { auto rr = __builtin_amdgcn_permlane32_swap(__float_as_uint(v), __float_as_uint(v), false, false); return fmaxf(__uint_as_float(rr[0]), __uint_as_float(rr[1])); }
__device__ __forceinline__ float swapsum(float v) { auto rr = __builtin_amdgcn_permlane32_swap(__float_as_uint(v), __float_as_uint(v), false, false); return __uint_as_float(rr[0]) + __uint_as_float(rr[1]); }

__device__ __forceinline__ void unit(int b, int h, int qb, const bf16* Qb, const bf16* KVb, const bf16* KPE, const bf16* GB, bf16* Y, LAS unsigned char* lds, int tid, int lane, int wave) {
    const int r32 = lane & 31, hi = lane >> 5;
    const size_t rowbase = (size_t)b * SEQ; const int q0 = qb * 256;
    const int NT = 4 * qb + 4;
    const int srcKV = (tid >> 4) * 2048 + h * 256 + (tid & 15) * 8, srcPE = (tid >> 3) * 64 + (tid & 7) * 8;
    const int dstK = (tid >> 4) * KS + (tid & 15) * 16, dstV = (tid >> 4) * VS + (tid & 15) * 16, dstPE = (tid >> 3) * KS + 256 + (tid & 7) * 16;
    v4u kst[3], vst[2];
#define ATT_LOAD(t) do { const size_t kr = rowbase + (size_t)64 * (t); const bf16* kvp = KVb + kr * 2048 + srcKV; \
        kst[0] = *(const GAS v4u*)(kvp); kst[1] = *(const GAS v4u*)(kvp + 32 * 2048); kst[2] = *(const GAS v4u*)(KPE + kr * 64 + srcPE); \
        vst[0] = *(const GAS v4u*)(kvp + 128); vst[1] = *(const GAS v4u*)(kvp + 128 + 32 * 2048); } while (0)
#define ATT_WRITE(buf) do { LAS unsigned char* kb_ = lds + K_OFF + (buf) * KB_BYTES; LAS unsigned char* vb_ = lds + V_OFF + (buf) * VB_BYTES; \
        *(LAS v4u*)(kb_ + dstK) = kst[0]; *(LAS v4u*)(kb_ + dstK + 32 * KS) = kst[1]; *(LAS v4u*)(kb_ + dstPE) = kst[2]; \
        *(LAS v4u*)(vb_ + dstV) = vst[0]; *(LAS v4u*)(vb_ + dstV + 32 * VS) = vst[1]; } while (0)
    ATT_LOAD(0);
    bf16x8 qr[12];
    { const bf16* Qw = Qb + (rowbase + q0 + 32 * wave + r32) * 1536 + h * 192 + 8 * hi;
#pragma unroll
      for (int s = 0; s < 12; ++s) qr[s] = *(const GAS bf16x8*)(Qw + 16 * s); }
    float m = -1e30f, l = 0.f; f32x16 o[4];
#pragma unroll
    for (int d = 0; d < 4; ++d)
#pragma unroll
        for (int i = 0; i < 16; ++i) o[d][i] = 0.f;
    ATT_WRITE(0);
    __syncthreads();
    const int koff = r32 * KS + 16 * hi;
    const int voff = (4 * hi + ((lane & 15) >> 2)) * VS + (16 * ((lane >> 4) & 1) + 4 * (lane & 3)) * 2;
    for (int t = 0; t < NT; ++t) {
        const int cur = t & 1;
        if (t + 1 < NT) ATT_LOAD(t + 1);
        const int jb = t - 4 * qb;
        const bool dead = jb >= 0 && 64 * jb > 32 * wave + 31;
        if (!dead) {
            const LAS unsigned char* Kc = lds + K_OFF + cur * KB_BYTES + koff;
            f32x16 p0, p1;
#pragma unroll
            for (int i = 0; i < 16; ++i) { p0[i] = 0.f; p1[i] = 0.f; }
#pragma unroll
            for (int s = 0; s < 12; ++s) {
                const bf16x8 k0 = *(const LAS bf16x8*)(Kc + 32 * s), k1 = *(const LAS bf16x8*)(Kc + 32 * KS + 32 * s);
                p0 = __builtin_amdgcn_mfma_f32_32x32x16_bf16(k0, qr[s], p0, 0, 0, 0);
                p1 = __builtin_amdgcn_mfma_f32_32x32x16_bf16(k1, qr[s], p1, 0, 0, 0);
            }
            if (jb >= 0 && 64 * jb + 63 > 32 * wave) {
                const int dq = 32 * wave + r32 - 64 * jb - 4 * hi;
#pragma unroll
                for (int i = 0; i < 16; ++i) { const int c = (i & 3) + 8 * (i >> 2);
                    if (c > dq) p0[i] = -__builtin_inff();
                    if (c + 32 > dq) p1[i] = -__builtin_inff(); }
            }
            float rm = fmaxf(p0[0], p1[0]);
#pragma unroll
            for (int i = 1; i < 16; ++i) rm = fmaxf(rm, fmaxf(p0[i], p1[i]));
            rm = swapmax(rm);
            const float mn = fmaxf(m, rm), alpha = __builtin_amdgcn_exp2f(m - mn); m = mn;
            float rs = 0.f;
#pragma unroll
            for (int i = 0; i < 16; ++i) { p0[i] = __builtin_amdgcn_exp2f(p0[i] - mn); p1[i] = __builtin_amdgcn_exp2f(p1[i] - mn); rs += p0[i] + p1[i]; }
            l = l * alpha + swapsum(rs);
#pragma unroll
            for (int d = 0; d < 4; ++d)
#pragma unroll
                for (int i = 0; i < 16; ++i) o[d][i] *= alpha;
            bf16x8 pf[4];
            { v4u w;
              w.x = cvtpk(p0[0], p0[1]); w.y = cvtpk(p0[2], p0[3]); w.z = cvtpk(p0[4], p0[5]); w.w = cvtpk(p0[6], p0[7]); pf[0] = __builtin_bit_cast(bf16x8, w);
              w.x = cvtpk(p0[8], p0[9]); w.y = cvtpk(p0[10], p0[11]); w.z = cvtpk(p0[12], p0[13]); w.w = cvtpk(p0[14], p0[15]); pf[1] = __builtin_bit_cast(bf16x8, w);
              w.x = cvtpk(p1[0], p1[1]); w.y = cvtpk(p1[2], p1[3]); w.z = cvtpk(p1[4], p1[5]); w.w = cvtpk(p1[6], p1[7]); pf[2] = __builtin_bit_cast(bf16x8, w);
              w.x = cvtpk(p1[8], p1[9]); w.y = cvtpk(p1[10], p1[11]); w.z = cvtpk(p1[12], p1[13]); w.w = cvtpk(p1[14], p1[15]); pf[3] = __builtin_bit_cast(bf16x8, w); }
            const LAS unsigned char* Vc = lds + V_OFF + cur * VB_BYTES + voff;
#pragma unroll
            for (int d = 0; d < 4; ++d)
#pragma unroll
                for (int ks = 0; ks < 4; ++ks) {
                    const s16x4 lo = vtr(Vc + ks * 16 * VS + d * 64), hh = vtr(Vc + ks * 16 * VS + 8 * VS + d * 64);
                    const bf16x8 a = {lo[0], lo[1], lo[2], lo[3], hh[0], hh[1], hh[2], hh[3]};
                    o[d] = __builtin_amdgcn_mfma_f32_32x32x16_bf16(a, pf[ks], o[d], 0, 0, 0);
                    if (ks == 3) __builtin_amdgcn_sched_barrier(0);
                }
        }
        if (t + 1 < NT) ATT_WRITE(cur ^ 1);
        __syncthreads();
    }
#undef ATT_LOAD
#undef ATT_WRITE
    {
        const float inv = 1.0f / l;
        LAS unsigned char* st = lds + (32 * wave + r32) * OS;
#pragma unroll
        for (int d = 0; d < 4; ++d)
#pragma unroll
            for (int g = 0; g < 4; ++g) { v2u w; w.x = cvtpk(o[d][4 * g] * inv, o[d][4 * g + 1] * inv); w.y = cvtpk(o[d][4 * g + 2] * inv, o[d][4 * g + 3] * inv);
                *(LAS v2u*)(st + (32 * d + 8 * g + 4 * hi) * 2) = w; }
        LDS_WAIT(); asm volatile("" ::: "memory");
#pragma unroll
        for (int i = 0; i < 8; ++i) { const int id = lane + 64 * i, row = 32 * wave + (id >> 4), ch = id & 15;
            const v4u ov = *(const LAS v4u*)(lds + row * OS + ch * 16);
            const size_t gi = (rowbase + q0 + row) * 1024 + h * 128 + ch * 8;
            const v4u gv = *(const GAS v4u*)(GB + gi), yv = *(const GAS v4u*)(Y + gi);
            float of[8], gf[8], yf[8]; unpack8(ov, of); unpack8(gv, gf); unpack8(yv, yf);
            v4u r; r.x = pk2(yf[0] + gf[0] * of[0], yf[1] + gf[1] * of[1]); r.y = pk2(yf[2] + gf[2] * of[2], yf[3] + gf[3] * of[3]);
            r.z = pk2(yf[4] + gf[4] * of[4], yf[5] + gf[5] * of[5]); r.w = pk2(yf[6] + gf[6] * of[6], yf[7] + gf[7] * of[7]);
            *(GAS v4u*)(Y + gi) = r; }
    }
    __syncthreads();
}
__device__ __forceinline__ void phase(const bf16* Qb, const bf16* KVb, const bf16* KPE, const bf16* GB, bf16* Y, LAS unsigned char* lds, int tid, int lane, int wave, int G) {
    const int bx = blockIdx.x, vcu = (G % 8 == 0) ? (bx % 8) * (G / 8) + bx / 8 : bx;
    for (int pr = vcu; pr < 256; pr += G) {
        const int bh = pr >> 3, s = pr & 7, b = bh >> 3, h = bh & 7;
        unit(b, h, 15 - s, Qb, KVb, KPE, GB, Y, lds, tid, lane, wave);
        unit(b, h, s, Qb, KVb, KPE, GB, Y, lds, tid, lane, wave);
    }
}
}
namespace mls {
using attn::cvtpk; using attn::vtr; using attn::swapsum; using attn::crow;
__device__ __forceinline__ float scan_add(float v, int lane) {
#pragma unroll
    for (int o = 1; o < 64; o <<= 1) { const float t = __shfl_up(v, o); if (lane >= o) v += t; }
    return v;
}
__device__ __forceinline__ float scan_max(float v, int lane) {
#pragma unroll
    for (int o = 1; o < 64; o <<= 1) { const float t = __shfl_up(v, o); if (lane >= o) v = fmaxf(v, t); }
    return v;
}
__device__ __forceinline__ v4u scale8(v4u w, float s) { float f[8]; unpack8(w, f); v4u o; o.x = cvtpk(f[0] * s, f[1] * s); o.y = cvtpk(f[2] * s, f[3] * s); o.z = cvtpk(f[4] * s, f[5] * s); o.w = cvtpk(f[6] * s, f[7] * s); return o; }

constexpr int A_KS = 320, A_VS = 576, A_KT = 0, A_VT = 64 * A_KS, A_WK = A_VT + 64 * A_VS, A_ST = 65536, A_STS = 272;
__device__ __forceinline__ void phaseA(const bf16* Kc, const bf16* V, const float* IF, bf16* CST, float* NST, float* SCAL, LAS unsigned char* lds, int tid, int lane, int wave, int G) {
    const int r32 = lane & 31, hi = lane >> 5, q4 = (lane & 15) >> 2, p4 = lane & 3, blk = (lane >> 4) & 1;
    for (int un = blockIdx.x; un < 1024; un += G) {
        const int bh = un >> 6, c = un & 63, b = bh >> 2, h = bh & 3; const size_t rowbase = (size_t)b * SEQ + 64 * c;
        const float ig = IF[(rowbase + lane) * 8 + h], lf = IF[(rowbase + lane) * 8 + 4 + h];
        const float bcs = scan_add(lf, lane), u = ig - bcs, pm63 = wave_max(u), Bc = __shfl(bcs, 63), wk = __expf(u - pm63);
        if (wave == 0) { ((LAS float*)(lds + A_WK))[lane] = wk; if (lane == 0) { SCAL[un * 2] = Bc; SCAL[un * 2 + 1] = pm63; } }
#pragma unroll
        for (int i = 0; i < 2; ++i) { const int row = (tid >> 4) + 32 * i, ch = tid & 15;
            *(LAS v4u*)(lds + A_KT + row * A_KS + ch * 16) = *(const GAS v4u*)(Kc + (rowbase + row) * 512 + h * 128 + ch * 8); }
#pragma unroll
        for (int i = 0; i < 4; ++i) { const int row = (tid >> 5) + 16 * i, ch = tid & 31;
            const v4u w = *(const GAS v4u*)(V + (rowbase + row) * 1024 + h * 256 + ch * 8);
            *(LAS v4u*)(lds + A_VT + row * A_VS + ch * 16) = scale8(w, __shfl(wk, row)); }
        __syncthreads();
        f32x16 acc[4], nacc;
#pragma unroll
        for (int d = 0; d < 4; ++d)
#pragma unroll
            for (int i = 0; i < 16; ++i) acc[d][i] = 0.f;
#pragma unroll
        for (int i = 0; i < 16; ++i) nacc[i] = 0.f;
        const LAS unsigned char* kb = lds + A_KT + (8 * hi + q4) * A_KS + (16 * blk + 4 * p4) * 2;
        const LAS unsigned char* vb = lds + A_VT + (8 * hi + q4) * A_VS + (32 * wave + 16 * blk + 4 * p4) * 2;
#pragma unroll
        for (int ks = 0; ks < 4; ++ks) {
            const s16x4 v0 = vtr(vb + ks * 16 * A_VS), v1 = vtr(vb + ks * 16 * A_VS + 4 * A_VS);
            const bf16x8 vf = {v0[0], v0[1], v0[2], v0[3], v1[0], v1[1], v1[2], v1[3]};
            bf16x8 wf;
            { const f32x4 w0 = *(const LAS f32x4*)(lds + A_WK + (16 * ks + 8 * hi) * 4), w1 = *(const LAS f32x4*)(lds + A_WK + (16 * ks + 8 * hi + 4) * 4);
              v4u ww; ww.x = cvtpk(w0[0], w0[1]); ww.y = cvtpk(w0[2], w0[3]); ww.z = cvtpk(w1[0], w1[1]); ww.w = cvtpk(w1[2], w1[3]); wf = __builtin_bit_cast(bf16x8, ww); }
#pragma unroll
            for (int d = 0; d < 4; ++d) {
                const s16x4 k0 = vtr(kb + ks * 16 * A_KS + d * 64), k1 = vtr(kb + ks * 16 * A_KS + 4 * A_KS + d * 64);
                const bf16x8 kf = {k0[0], k0[1], k0[2], k0[3], k1[0], k1[1], k1[2], k1[3]};
                acc[d] = __builtin_amdgcn_mfma_f32_32x32x16_bf16(kf, vf, acc[d], 0, 0, 0);
                if (d == (wave & 3) && wave < 4) nacc = __builtin_amdgcn_mfma_f32_32x32x16_bf16(kf, wf, nacc, 0, 0, 0);
            }
        }
        if (wave < 4 && r32 == 0) {
#pragma unroll
            for (int g = 0; g < 4; ++g) *(GAS f32x4*)(NST + (size_t)un * 128 + 32 * wave + 8 * g + 4 * hi) = (f32x4){nacc[4 * g], nacc[4 * g + 1], nacc[4 * g + 2], nacc[4 * g + 3]};
        }
        LAS unsigned char* st = lds + A_ST + wave * (32 * A_STS);
#pragma unroll
        for (int d = 0; d < 4; ++d)
#pragma unroll
            for (int g = 0; g < 4; ++g) { v2u w; w.x = cvtpk(acc[d][4 * g], acc[d][4 * g + 1]); w.y = cvtpk(acc[d][4 * g + 2], acc[d][4 * g + 3]);
                *(LAS v2u*)(st + r32 * A_STS + (32 * d + 8 * g + 4 * hi) * 2) = w; }
        LDS_WAIT(); asm volatile("" ::: "memory");
#pragma unroll
        for (int i = 0; i < 8; ++i) { const int id = lane + 64 * i, row = id >> 4, ch = id & 15;
            *(GAS v4u*)(CST + (size_t)un * 32768 + (32 * wave + row) * 128 + ch * 8) = *(const LAS v4u*)(st + row * A_STS + ch * 16); }
        __syncthreads();
    }
}
__device__ __forceinline__ void phaseB(bf16* CST, float* NST, const float* SCAL, float* MST, int tid, int G) {
    for (int item = blockIdx.x * NTHREADS + tid; item < 16 * 4096; item += G * NTHREADS) {
        const int bh = item >> 12, e8 = item & 4095;
        bf16* cp = CST + (size_t)bh * 64 * 32768 + e8 * 8;
        float S[8]; float m = 0.f;
#pragma unroll
        for (int e = 0; e < 8; ++e) S[e] = 0.f;
        float ns[8];
#pragma unroll
        for (int e = 0; e < 8; ++e) ns[e] = 0.f;
        for (int c0 = 0; c0 < 64; c0 += 8) {
            v4u dv[8]; f32x4 dn0[8], dn1[8];
#pragma unroll
            for (int j = 0; j < 8; ++j) dv[j] = *(const GAS v4u*)(cp + (size_t)(c0 + j) * 32768);
            if (e8 < 16) {
#pragma unroll
                for (int j = 0; j < 8; ++j) { const float* np = NST + ((size_t)bh * 64 + c0 + j) * 128 + e8 * 8; dn0[j] = *(const GAS f32x4*)np; dn1[j] = *(const GAS f32x4*)(np + 4); }
            }
#pragma unroll
            for (int j = 0; j < 8; ++j) {
                const int un = bh * 64 + c0 + j; const float Bc = SCAL[un * 2], pm63 = SCAL[un * 2 + 1];
                const float Mx = fmaxf(m, pm63), a = __expf(m - Mx), bb = __expf(pm63 - Mx);
                if (e8 == 0) MST[un] = m;
                v4u o; o.x = pk2(S[0], S[1]); o.y = pk2(S[2], S[3]); o.z = pk2(S[4], S[5]); o.w = pk2(S[6], S[7]);
                *(GAS v4u*)(cp + (size_t)(c0 + j) * 32768) = o;
                float f[8]; unpack8(dv[j], f);
#pragma unroll
                for (int e = 0; e < 8; ++e) S[e] = a * S[e] + bb * f[e];
                if (e8 < 16) { float* np = NST + (size_t)un * 128 + e8 * 8;
                    *(GAS f32x4*)np = (f32x4){ns[0], ns[1], ns[2], ns[3]}; *(GAS f32x4*)(np + 4) = (f32x4){ns[4], ns[5], ns[6], ns[7]};
#pragma unroll
                    for (int e = 0; e < 4; ++e) { ns[e] = a * ns[e] + bb * dn0[j][e]; ns[4 + e] = a * ns[4 + e] + bb * dn1[j][e]; } }
                m = Bc + Mx;
            }
        }
    }
}
constexpr int C_RS = 272, C_VS = 576, C_QT = 0, C_KT = 64 * C_RS, C_VT = 2 * 64 * C_RS, C_CT = C_VT + 64 * C_VS, C_SC = C_CT + 256 * C_RS, C_OS = 528;
static_assert(C_SC + 2560 <= MISC_OFF && 64 * C_OS <= C_VT, "mLSTM output phase LDS map");
__device__ __forceinline__ void phaseC(const bf16* Qc, const bf16* Kc, const bf16* V, const float* IF, const bf16* CST, const float* NST, const float* MST, const bf16* OGA, const float* hnw, bf16* Y,
                                       LAS unsigned char* lds, int tid, int lane, int wave, int G) {
    const int r32 = lane & 31, hi = lane >> 5, q4 = (lane & 15) >> 2, p4 = lane & 3, blk = (lane >> 4) & 1, tb = wave & 1, vq = wave >> 1;
    LAS float* su = (LAS float*)(lds + C_SC); LAS float* sM = su + 64; LAS float* sw = su + 128; LAS float* se = su + 192; LAS float* sn = su + 256; LAS float* ssq = su + 384;
    for (int un = blockIdx.x; un < 1024; un += G) {
        const int bh = un >> 6, c = un & 63, b = bh >> 2, h = bh & 3; const size_t rowbase = (size_t)b * SEQ + 64 * c;
#pragma unroll
        for (int i = 0; i < 2; ++i) { const int row = (tid >> 4) + 32 * i, ch = tid & 15;
            *(LAS v4u*)(lds + C_QT + row * C_RS + ch * 16) = *(const GAS v4u*)(Qc + (rowbase + row) * 512 + h * 128 + ch * 8);
            *(LAS v4u*)(lds + C_KT + row * C_RS + ch * 16) = *(const GAS v4u*)(Kc + (rowbase + row) * 512 + h * 128 + ch * 8); }
#pragma unroll
        for (int i = 0; i < 4; ++i) { const int row = (tid >> 5) + 16 * i, ch = tid & 31;
            *(LAS v4u*)(lds + C_VT + row * C_VS + ch * 16) = *(const GAS v4u*)(V + (rowbase + row) * 1024 + h * 256 + ch * 8); }
#pragma unroll
        for (int i = 0; i < 8; ++i) { const int row = (tid >> 4) + 32 * i, ch = tid & 15;
            *(LAS v4u*)(lds + C_CT + row * C_RS + ch * 16) = *(const GAS v4u*)(CST + (size_t)un * 32768 + row * 128 + ch * 8); }
        if (tid < 128) sn[tid] = NST[(size_t)un * 128 + tid];
        if (wave == 0) {
            const float mc = MST[un], ig = IF[(rowbase + lane) * 8 + h], lf = IF[(rowbase + lane) * 8 + 4 + h];
            const float bcs = scan_add(lf, lane), u = ig - bcs, pm = scan_max(u, lane), Mt = fmaxf(mc, pm);
            su[lane] = u; sM[lane] = Mt; sw[lane] = __expf(mc - Mt); se[lane] = __expf(-(bcs + Mt));
        }
        __syncthreads();
        const int t = 32 * tb + r32;
        const float Mt = sM[t], wt = sw[t], ebm = se[t];
        bf16x8 qf[8];
#pragma unroll
        for (int ks = 0; ks < 8; ++ks) qf[ks] = *(const LAS bf16x8*)(lds + C_QT + t * C_RS + (16 * ks + 8 * hi) * 2);
        bf16x8 pf[4]; float denp = 0.f;
#pragma unroll
        for (int sb = 0; sb < 2; ++sb) {
            if (sb <= tb) {
                f32x16 X;
#pragma unroll
                for (int i = 0; i < 16; ++i) X[i] = 0.f;
#pragma unroll
                for (int ks = 0; ks < 8; ++ks) { const bf16x8 kf = *(const LAS bf16x8*)(lds + C_KT + (32 * sb + r32) * C_RS + (16 * ks + 8 * hi) * 2);
                    X = __builtin_amdgcn_mfma_f32_32x32x16_bf16(kf, qf[ks], X, 0, 0, 0); }
#pragma unroll
                for (int g = 0; g < 4; ++g) { const f32x4 uu = *(const LAS f32x4*)(su + 32 * sb + 8 * g + 4 * hi);
#pragma unroll
                    for (int e = 0; e < 4; ++e) { float w = __expf(uu[e] - Mt); if (sb == tb && (8 * g + 4 * hi + e) > r32) w = 0.f;
                        const float p = X[4 * g + e] * w; denp += p; X[4 * g + e] = p; } }
                v4u w0, w1;
                w0.x = cvtpk(X[0], X[1]); w0.y = cvtpk(X[2], X[3]); w0.z = cvtpk(X[4], X[5]); w0.w = cvtpk(X[6], X[7]);
                w1.x = cvtpk(X[8], X[9]); w1.y = cvtpk(X[10], X[11]); w1.z = cvtpk(X[12], X[13]); w1.w = cvtpk(X[14], X[15]);
                pf[2 * sb] = __builtin_bit_cast(bf16x8, w0); pf[2 * sb + 1] = __builtin_bit_cast(bf16x8, w1);
            } else { pf[2 * sb] = (bf16x8){0, 0, 0, 0, 0, 0, 0, 0}; pf[2 * sb + 1] = (bf16x8){0, 0, 0, 0, 0, 0, 0, 0}; }
        }
        const float den_intra = swapsum(denp);
        f32x16 acc1[2], acc2[2];
#pragma unroll
        for (int vb = 0; vb < 2; ++vb)
#pragma unroll
            for (int i = 0; i < 16; ++i) { acc1[vb][i] = 0.f; acc2[vb][i] = 0.f; }
#pragma unroll
        for (int vb = 0; vb < 2; ++vb) {
            const int VBk = 2 * vq + vb;
            const LAS unsigned char* vp = lds + C_VT + (4 * hi + q4) * C_VS + (32 * VBk + 16 * blk + 4 * p4) * 2;
#pragma unroll
            for (int ks = 0; ks < 4; ++ks) {
                if (ks < 2 * (tb + 1)) {
                    const s16x4 lo = vtr(vp + ks * 16 * C_VS), hh = vtr(vp + ks * 16 * C_VS + 8 * C_VS);
                    const bf16x8 a = {lo[0], lo[1], lo[2], lo[3], hh[0], hh[1], hh[2], hh[3]};
                    acc1[vb] = __builtin_amdgcn_mfma_f32_32x32x16_bf16(a, pf[ks], acc1[vb], 0, 0, 0);
                }
            }
#pragma unroll
            for (int ks = 0; ks < 8; ++ks) { const bf16x8 cf = *(const LAS bf16x8*)(lds + C_CT + (32 * VBk + r32) * C_RS + (16 * ks + 8 * hi) * 2);
                acc2[vb] = __builtin_amdgcn_mfma_f32_32x32x16_bf16(cf, qf[ks], acc2[vb], 0, 0, 0); }
        }
        float nqp = 0.f;
#pragma unroll
        for (int j = 0; j < 8; ++j) { float qv[8]; unpack8(*(const LAS v4u*)(lds + C_QT + t * C_RS + (64 * hi + 8 * j) * 2), qv);
            const f32x4 n0 = *(const LAS f32x4*)(sn + 64 * hi + 8 * j), n1 = *(const LAS f32x4*)(sn + 64 * hi + 8 * j + 4);
            nqp += qv[0] * n0[0] + qv[1] * n0[1] + qv[2] * n0[2] + qv[3] * n0[3] + qv[4] * n1[0] + qv[5] * n1[1] + qv[6] * n1[2] + qv[7] * n1[3]; }
        const float den = den_intra + wt * swapsum(nqp), rden = 1.0f / fmaxf(fabsf(den), ebm);
        float sq = 0.f;
#pragma unroll
        for (int vb = 0; vb < 2; ++vb)
#pragma unroll
            for (int i = 0; i < 16; ++i) { const float hv = (acc1[vb][i] + wt * acc2[vb][i]) * rden; acc1[vb][i] = hv; sq += hv * hv; }
        sq = swapsum(sq);
        if (hi == 0) ssq[(tb * 4 + vq) * 32 + r32] = sq;
        __syncthreads();
        const float tot = ssq[(tb * 4 + 0) * 32 + r32] + ssq[(tb * 4 + 1) * 32 + r32] + ssq[(tb * 4 + 2) * 32 + r32] + ssq[(tb * 4 + 3) * 32 + r32];
        const float rms = 1.0f / sqrtf(tot * (1.f / 256.f) + EPS);
#pragma unroll
        for (int vb = 0; vb < 2; ++vb)
#pragma unroll
            for (int g = 0; g < 4; ++g) { v2u w; w.x = cvtpk(acc1[vb][4 * g] * rms, acc1[vb][4 * g + 1] * rms); w.y = cvtpk(acc1[vb][4 * g + 2] * rms, acc1[vb][4 * g + 3] * rms);
                *(LAS v2u*)(lds + t * C_OS + (32 * (2 * vq + vb) + 8 * g + 4 * hi) * 2) = w; }
        __syncthreads();
#pragma unroll
        for (int i = 0; i < 4; ++i) { const int id = tid + 512 * i, row = id >> 5, ch = id & 31;
            float ov[8], og[8]; unpack8(*(const LAS v4u*)(lds + row * C_OS + ch * 16), ov);
            const size_t gi = (rowbase + row) * 1024 + h * 256 + ch * 8;
            unpack8(*(const GAS v4u*)(OGA + gi), og);
            const f32x4 h0 = *(const f32x4*)(hnw + h * 256 + ch * 8), h1 = *(const f32x4*)(hnw + h * 256 + ch * 8 + 4);
            v4u r; r.x = pk2(ov[0] * og[0] * h0[0], ov[1] * og[1] * h0[1]); r.y = pk2(ov[2] * og[2] * h0[2], ov[3] * og[3] * h0[3]);
            r.z = pk2(ov[4] * og[4] * h1[0], ov[5] * og[5] * h1[1]); r.w = pk2(ov[6] * og[6] * h1[2], ov[7] * og[7] * h1[3]);
            *(GAS v4u*)(Y + gi) = r; }
        __syncthreads();
    }
}
}
#ifndef MK_ONE_LAUNCH
#define MK_ONE_LAUNCH 0
#endif
struct Args { const float* in[20]; float* out; unsigned char* ws; int ph_lo, ph_hi; };
__global__ void __launch_bounds__(NTHREADS, 2) fwd_kernel(Args args) {
    extern __shared__ __attribute__((aligned(16))) unsigned char lds_raw[];
    LAS unsigned char* lds = (LAS unsigned char*)lds_raw;
    volatile LAS unsigned* MISC = (volatile LAS unsigned*)(lds + MISC_OFF);
    const int wave = __builtin_amdgcn_readfirstlane((int)threadIdx.x >> 6);
    const int G = gridDim.x, gw = blockIdx.x * NWAVES + wave, NGW = G * NWAVES;
#define lane ((int)__builtin_amdgcn_mbcnt_hi(~0u, __builtin_amdgcn_mbcnt_lo(~0u, 0u)))
#define tid ((wave << 6) | lane)
    unsigned char* const ws = args.ws;
    gu32* ctl = (gu32*)(ws + WS_CTL);
#define WSP(T, off) ((T*)(ws + (off)))
#define p_mod WSP(float, WS_MOD)
#define p_rope WSP(float, WS_ROPE)
#define p_rstdq WSP(float, WS_RSTDQ)
#define p_rstdkv WSP(float, WS_RSTDKV)
#define p_IFb WSP(float, WS_IF)
#define p_WIN WSP(bf16, WS_WIN)
#define p_WUQ WSP(bf16, WS_WUQ)
#define p_WUKV WSP(bf16, WS_WUKV)
#define p_WOUT WSP(bf16, WS_WOUT)
#define p_WFF1 WSP(bf16, WS_WFF1)
#define p_WFF2 WSP(bf16, WS_WFF2)
#define p_H WSP(bf16, WS_H)
#define p_QC WSP(bf16, WS_QC)
#define p_KC WSP(bf16, WS_KC)
#define p_QKPRE WSP(bf16, WS_QKPRE)
#define p_Y WSP(bf16, WS_Y)
#define p_VB WSP(bf16, WS_V)
#define p_OGA WSP(bf16, WS_OGA)
#define p_GB WSP(bf16, WS_GB)
#define p_QB WSP(bf16, WS_QB)
#define p_KPE WSP(bf16, WS_KPE)
#define p_CQ WSP(bf16, WS_CQ)
#define p_CKV WSP(bf16, WS_CKV)
#define p_KVB ((bf16*)args.out)
#define p_A2 WSP(bf16, WS_A2)
#define p_Y1 WSP(float, WS_Y1)
#define p_Y2 WSP(float, WS_Y2)
#define p_x (args.in[0])
#define p_out (args.out)

    { const int t0 = tid; if (t0 < 64) MISC[t0] = 0u; }
    __syncthreads();
    XcdBarrier bar; bar.bar = (unsigned*)(ctl + CW_BAR); bar.x = 0; bar.st = nullptr;
    if (MK_ONE_LAUNCH) bar = xcd_barrier_post((unsigned*)(ctl + CW_BAR), MISC + 8);
    const int lo = args.ph_lo, hi = args.ph_hi;
#define IN(k) (lo <= (k) && (k) < hi)
#define SEAM(k) do { if (MK_ONE_LAUNCH && IN(k) && IN((k) + 1)) xcd_barrier(bar); } while (0)

    if (IN(0)) {
        P0Args a{args.in[1], args.in[2], args.in[3], args.in[8], args.in[15], args.in[16], args.in[17], args.in[18], args.in[19], args.in[13], args.in[14], p_mod, p_rope, p_WIN, p_WUQ, p_WUKV, p_WOUT, p_WFF1, p_WFF2};
        p0_prologue(a, lds, tid, lane, wave, G);
    }
    SEAM(0);
    if (IN(1)) p1_rows(p_x, args.in[4], p_mod, p_H, lane, gw, NGW);
    SEAM(1);
    if (IN(2)) {
        pg8::Gemm g{p_H, p_WIN, M, NIN, DM}; pg8::StaticOrder S; S.init(M, NIN, G, (int)blockIdx.x);
        pg8::EpiInProj E{ws, args.in[11]};
        pg8::gemm_phase<pg8::EpiInProj, pg8::StaticOrder, true, true>(lds, g, S, E, wave);
    }
    SEAM(2);
    if (IN(3)) p3_conv(p_QKPRE, args.in[9], args.in[10], p_QC, p_KC, p_CQ, p_CKV, p_rstdq, p_rstdkv, tid, lane, wave, G);
    SEAM(3);
    if (IN(4)) mls::phaseA(p_KC, p_VB, p_IFb, (bf16*)args.out, WSP(float, WS_NST), WSP(float, WS_SCAL), lds, tid, lane, wave, G);
    SEAM(4);
    if (IN(5)) mls::phaseB((bf16*)args.out, WSP(float, WS_NST), WSP(float, WS_SCAL), WSP(float, WS_MST), tid, G);
    SEAM(5);
    if (IN(6)) mls::phaseC(p_QC, p_KC, p_VB, p_IFb, (const bf16*)args.out, WSP(float, WS_NST), WSP(float, WS_MST), p_OGA, args.in[12], p_Y, lds, tid, lane, wave, G);
    SEAM(6);
    if (IN(7)) {
        { pg8::Gemm g{p_CQ, p_WUQ, M, NQ, QRANK}; pg8::StaticOrder S; S.init(M, NQ, G, (int)blockIdx.x);
          pg8::EpiUpQ E{ws, QSCALE};
          pg8::gemm_phase<pg8::EpiUpQ, pg8::StaticOrder, true, true>(lds, g, S, E, wave); }
        { pg8::Gemm g{p_CKV, p_WUKV, M, NKV, KVRANK}; pg8::StaticOrder S; S.init(M, NKV, G, (int)blockIdx.x);
          pg8::EpiBf16<0, true> E{p_KVB, NKV, p_rstdkv};
          pg8::gemm_phase<pg8::EpiBf16<0, true>, pg8::StaticOrder, true, true>(lds, g, S, E, wave); }
    }
    SEAM(7);
    if (IN(8)) attn::phase(p_QB, p_KVB, p_KPE, p_GB, p_Y, lds, tid, lane, wave, G);
    SEAM(8);
    if (IN(9)) {
        pg8::Gemm g{p_Y, p_WOUT, M, DM, DM}; pg8::StaticOrder S; S.init(M, DM, G, (int)blockIdx.x);
        pg8::EpiF32 E{p_Y1, DM};
        pg8::gemm_phase<pg8::EpiF32, pg8::StaticOrder, true, true>(lds, g, S, E, wave);
    }
    SEAM(9);
    if (IN(10)) p10_rows(p_x, p_Y1, args.in[5], args.in[6], p_mod, p_out, p_H, lane, gw, NGW);
    SEAM(10);
    if (IN(11)) {
        pg8::Gemm g{p_H, p_WFF1, M, DFF, DM}; pg8::StaticOrder S; S.init(M, DFF, G, (int)blockIdx.x);
        pg8::EpiBf16<1, false> E{p_A2, DFF, nullptr};
        pg8::gemm_phase<pg8::EpiBf16<1, false>, pg8::StaticOrder, true, true>(lds, g, S, E, wave);
    }
    SEAM(11);
    if (IN(12)) {
        pg8::Gemm g{p_A2, p_WFF2, M, DM, DFF}; pg8::StaticOrder S; S.init(M, DM, G, (int)blockIdx.x);
        pg8::EpiF32 E{p_Y2, DM};
        pg8::gemm_phase<pg8::EpiF32, pg8::StaticOrder, true, true>(lds, g, S, E, wave);
    }
    SEAM(12);
    if (IN(13)) p13_rows(p_Y2, args.in[7], p_mod, p_out, lane, gw, NGW);
#undef IN
#undef SEAM
#undef lane
#undef tid
#undef p_x
#undef p_out
#undef p_mod
#undef p_rope
#undef p_H
#undef p_Y
#undef p_Y1
#undef p_Y2
#undef p_A2
}

extern "C" void kernel_launch(void* const* d_in, const int* in_sizes, int n_in, void* d_out, int out_size, void* d_ws, size_t ws_size, hipStream_t stream) {
    static int grid = 0;
    if (grid == 0) {
        if (n_in != 20 || in_sizes[0] != M * DM || out_size != M * DM || ws_size < WS_END) { fprintf(stderr, "kernel_launch: unexpected shapes (n_in %d, in0 %d, out %d, ws %zu)\n", n_in, n_in > 0 ? in_sizes[0] : -1, out_size, ws_size); grid = -1; return; }
        int dev = 0, cus = 0, per_cu = 0;
        if (hipGetDevice(&dev) != hipSuccess || hipDeviceGetAttribute(&cus, hipDeviceAttributeMultiprocessorCount, dev) != hipSuccess) { grid = -1; return; }
        if (hipFuncSetAttribute((const void*)fwd_kernel, hipFuncAttributeMaxDynamicSharedMemorySize, LDS_BYTES) != hipSuccess) { fprintf(stderr, "kernel_launch: hipFuncSetAttribute failed\n"); grid = -1; return; }
        if (hipOccupancyMaxActiveBlocksPerMultiprocessor(&per_cu, (const void*)fwd_kernel, NTHREADS, LDS_BYTES) != hipSuccess || per_cu < 1) fprintf(stderr, "kernel_launch: occupancy query reports %d\n", per_cu);
        (void)hipGetLastError();
        grid = cus;
    }
    if (grid < 0) return;
    (void)hipMemsetAsync((char*)d_ws + WS_CTL, 0, CTL_ZERO_BYTES, stream);
    Args a{};
    for (int i = 0; i < 20; ++i) a.in[i] = (const float*)d_in[i];
    a.out = (float*)d_out; a.ws = (unsigned char*)d_ws;
#if MK_ONE_LAUNCH
    a.ph_lo = 0; a.ph_hi = NPHASE;
    hipLaunchKernelGGL(fwd_kernel, dim3(grid), dim3(NTHREADS), LDS_BYTES, stream, a);
#else
    for (int p = 0; p < NPHASE; ++p) {
        a.ph_lo = p; a.ph_hi = p + 1;
        hipLaunchKernelGGL(fwd_kernel, dim3(grid), dim3(NTHREADS), LDS_BYTES, stream, a);
    }
#endif
}
```
